# Optimizing an MI355X kernel written in HIP

```python
import math
import jax, jax.numpy as jnp
from jax import lax
import numpy as np

D_MODEL = 1024
BATCH = 8
SEQ = 4096
DEPTH = 4

N_MIXERS = 3
N_A = (DEPTH + 2) // 3
N_B = (DEPTH + 1) // 3
N_C = DEPTH // 3
N_META = 16
Q_BLOCK = 128
EPS = 1e-6

MLA_HEADS = 16
MLA_Q_RANK = 256
MLA_KV_RANK = 128
MLA_NOPE = 64
MLA_ROPE = 32
MLA_V = 64
ROPE_THETA = 10000.0

SC_WIDTH = 3

DIFF_HEADS = 8
DIFF_HEAD_DIM = D_MODEL // DIFF_HEADS // 2
LAMBDA_INIT_SCALE = 0.1

D_FF = 2816
FFN_CONV_WIDTH = 3

kernel_name = "hybrid_mla_shortconv_diffattn_trunk"


def rms_norm(x, g):
    xf = x.astype(jnp.float32)
    y = xf * lax.rsqrt(jnp.mean(xf * xf, axis=-1, keepdims=True) + EPS)
    return (y * g.astype(jnp.float32)).astype(x.dtype)


def causal_dwconv(h, w):
    K = w.shape[0]
    L = h.shape[1]
    hp = jnp.pad(h, ((0, 0), (K - 1, 0), (0, 0)))
    y = w[K - 1] * hp[:, K - 1:K - 1 + L]
    for j in range(K - 1):
        y = y + w[j] * hp[:, j:j + L]
    return y


def rope_tables(L, dtype):
    inv_freq = ROPE_THETA ** (-jnp.arange(0, MLA_ROPE, 2, dtype=jnp.float32) / MLA_ROPE)
    ang = jnp.arange(L, dtype=jnp.float32)[:, None] * inv_freq[None, :]
    return jnp.cos(ang).astype(dtype), jnp.sin(ang).astype(dtype)


def apply_rope(x, cos, sin):
    x1, x2 = jnp.split(x, 2, axis=-1)
    return jnp.concatenate([x1 * cos - x2 * sin, x2 * cos + x1 * sin], axis=-1)


def alibi_slopes(n_heads):
    return 2.0 ** (-8.0 * jnp.arange(1, n_heads + 1, dtype=jnp.float32) / n_heads)


def sweep_causal_queries(block_fn, q):
    B, L = q.shape[0], q.shape[1]
    n_blk = (L - N_META) // Q_BLOCK
    pos = jnp.arange(L, dtype=jnp.int32)
    out_meta = block_fn(q[:, :N_META], pos[:N_META])
    q_rest = jnp.moveaxis(q[:, N_META:].reshape(B, n_blk, Q_BLOCK, *q.shape[2:]), 1, 0)
    pos_rest = pos[N_META:].reshape(n_blk, Q_BLOCK)
    out_rest = lax.map(lambda a: block_fn(a[0], a[1]), (q_rest, pos_rest))
    out_rest = jnp.moveaxis(out_rest, 0, 1).reshape(B, L - N_META, *out_rest.shape[3:])
    return jnp.concatenate([out_meta, out_rest], axis=1)


def mla_mixer(h, w_in, g_q, g_kv, w_uq, w_ukv, w_o, cos, sin):
    B, L, _ = h.shape
    c = h @ w_in
    c_q, c_kv, k_r = jnp.split(c, [MLA_Q_RANK, MLA_Q_RANK + MLA_KV_RANK], axis=-1)
    q = (rms_norm(c_q, g_q) @ w_uq).reshape(B, L, MLA_HEADS, MLA_NOPE + MLA_ROPE)
    kv = (rms_norm(c_kv, g_kv) @ w_ukv).reshape(B, L, MLA_HEADS, MLA_NOPE + MLA_V)
    q_nope, q_rope = jnp.split(q, [MLA_NOPE], axis=-1)
    k_nope, v = jnp.split(kv, [MLA_NOPE], axis=-1)
    q = jnp.concatenate([q_nope, apply_rope(q_rope, cos[:, None, :], sin[:, None, :])], axis=-1)
    k_rope = apply_rope(k_r, cos, sin)
    k = jnp.concatenate(
        [k_nope, jnp.broadcast_to(k_rope[:, :, None, :], (B, L, MLA_HEADS, MLA_ROPE))], axis=-1)
    scale = (MLA_NOPE + MLA_ROPE) ** -0.5
    k_pos = jnp.arange(L, dtype=jnp.int32)

    def block(qb, q_pos):
        s = jnp.einsum('bqhd,bkhd->bhqk', qb, k).astype(jnp.float32) * scale
        s = jnp.where(k_pos[None, :] <= q_pos[:, None], s, -jnp.inf)
        p = jax.nn.softmax(s, axis=-1).astype(v.dtype)
        return jnp.einsum('bhqk,bkhd->bqhd', p, v)

    o = sweep_causal_queries(block, q)
    return o.reshape(B, L, MLA_HEADS * MLA_V) @ w_o


def short_conv_mixer(h, w_in, w_conv, w_out):
    gate_b, gate_c, u = jnp.split(h @ w_in, 3, axis=-1)
    return (gate_b * causal_dwconv(gate_c * u, w_conv)) @ w_out


def diff_attn_mixer(h, w_in, lq1, lk1, lq2, lk2, g_sub, w_o, lambda_init):
    B, L, _ = h.shape
    H, d = DIFF_HEADS, DIFF_HEAD_DIM
    q, k, v = jnp.split(h @ w_in, 3, axis=-1)
    q = q.reshape(B, L, H, 2, d)
    k = k.reshape(B, L, H, 2, d)
    v = v.reshape(B, L, H, 2 * d)
    f32 = jnp.float32
    lam = (jnp.exp(jnp.sum(lq1.astype(f32) * lk1.astype(f32)))
           - jnp.exp(jnp.sum(lq2.astype(f32) * lk2.astype(f32))) + lambda_init)
    slopes = alibi_slopes(H)
    k_pos = jnp.arange(L, dtype=jnp.int32)
    scale = d ** -0.5

    def block(qb, q_pos):
        s = jnp.einsum('bqhmd,bkhmd->bhmqk', qb, k).astype(f32) * scale
        dist = (q_pos[:, None] - k_pos[None, :]).astype(f32)
        s = s - slopes[None, :, None, None, None] * dist
        s = jnp.where(k_pos[None, :] <= q_pos[:, None], s, -jnp.inf)
        p = jax.nn.softmax(s, axis=-1)
        a = (p[:, :, 0] - lam * p[:, :, 1]).astype(v.dtype)
        return jnp.einsum('bhqk,bkhe->bqhe', a, v)

    o = sweep_causal_queries(block, q)
    o = rms_norm(o, g_sub) * (1.0 - lambda_init)
    return o.reshape(B, L, H * 2 * d) @ w_o


def conv_glu_ffn(h, w_up, w_conv, w_down):
    g, u = jnp.split(causal_dwconv(h @ w_up, w_conv), 2, axis=-1)
    return (jax.nn.silu(g) * u) @ w_down


def setup_inputs(seed: int = 0) -> dict:
    key = jax.random.key(seed)
    ks = jax.random.split(key, 23)
    f32 = jnp.float32

    def nrm(k, shape, scale):
        return jax.random.normal(k, shape, f32) * scale

    def gain(k, shape):
        return 1.0 + 0.1 * jax.random.normal(k, shape, f32)

    D, F = D_MODEL, D_FF
    Hd = DIFF_HEADS * 2 * DIFF_HEAD_DIM
    return {
        "x": nrm(ks[0], (BATCH, SEQ, D), 1.0),
        "meta_tokens": nrm(ks[1], (N_META, D), 1.0),
        "norms": gain(ks[2], (DEPTH, 4, D)),
        "mla_w_in": nrm(ks[3], (N_A, D, MLA_Q_RANK + MLA_KV_RANK + MLA_ROPE), D ** -0.5),
        "mla_norm_q": gain(ks[4], (N_A, MLA_Q_RANK)),
        "mla_norm_kv": gain(ks[5], (N_A, MLA_KV_RANK)),
        "mla_w_uq": nrm(ks[6], (N_A, MLA_Q_RANK, MLA_HEADS * (MLA_NOPE + MLA_ROPE)), MLA_Q_RANK ** -0.5),
        "mla_w_ukv": nrm(ks[7], (N_A, MLA_KV_RANK, MLA_HEADS * (MLA_NOPE + MLA_V)), MLA_KV_RANK ** -0.5),
        "mla_w_o": nrm(ks[8], (N_A, MLA_HEADS * MLA_V, D), (MLA_HEADS * MLA_V) ** -0.5),
        "sc_w_in": nrm(ks[9], (N_B, D, 3 * D), D ** -0.5),
        "sc_conv": nrm(ks[10], (N_B, SC_WIDTH, D), SC_WIDTH ** -0.5),
        "sc_w_out": nrm(ks[11], (N_B, D, D), D ** -0.5),
        "diff_w_in": nrm(ks[12], (N_C, D, 3 * Hd), D ** -0.5),
        "diff_lambda_q1": nrm(ks[13], (N_C, DIFF_HEAD_DIM), LAMBDA_INIT_SCALE),
        "diff_lambda_k1": nrm(ks[14], (N_C, DIFF_HEAD_DIM), LAMBDA_INIT_SCALE),
        "diff_lambda_q2": nrm(ks[15], (N_C, DIFF_HEAD_DIM), LAMBDA_INIT_SCALE),
        "diff_lambda_k2": nrm(ks[16], (N_C, DIFF_HEAD_DIM), LAMBDA_INIT_SCALE),
        "diff_subln": gain(ks[17], (N_C, 2 * DIFF_HEAD_DIM)),
        "diff_w_o": nrm(ks[18], (N_C, Hd, D), Hd ** -0.5),
        "ffn_w_up": nrm(ks[19], (DEPTH, D, 2 * F), D ** -0.5),
        "ffn_conv": nrm(ks[20], (DEPTH, FFN_CONV_WIDTH, 2 * F), FFN_CONV_WIDTH ** -0.5),
        "ffn_w_down": nrm(ks[21], (DEPTH, F, D), F ** -0.5),
    }


def reference(x, meta_tokens, norms, mla_w_in, mla_norm_q, mla_norm_kv, mla_w_uq, mla_w_ukv,
              mla_w_o, sc_w_in, sc_conv, sc_w_out, diff_w_in, diff_lambda_q1, diff_lambda_k1,
              diff_lambda_q2, diff_lambda_k2, diff_subln, diff_w_o, ffn_w_up, ffn_conv, ffn_w_down):
    B = x.shape[0]
    meta = jnp.broadcast_to(meta_tokens[None].astype(x.dtype), (B, N_META, D_MODEL))
    h = jnp.concatenate([meta, x], axis=1)
    L = h.shape[1]
    cos, sin = rope_tables(L, x.dtype)
    for i in range(DEPTH):
        kind, j = i % N_MIXERS, i // N_MIXERS
        hn = rms_norm(h, norms[i, 0])
        if kind == 0:
            m = mla_mixer(hn, mla_w_in[j], mla_norm_q[j], mla_norm_kv[j], mla_w_uq[j],
                          mla_w_ukv[j], mla_w_o[j], cos, sin)
        elif kind == 1:
            m = short_conv_mixer(hn, sc_w_in[j], sc_conv[j], sc_w_out[j])
        else:
            lambda_init = 0.8 - 0.6 * math.exp(-0.3 * i)
            m = diff_attn_mixer(hn, diff_w_in[j], diff_lambda_q1[j], diff_lambda_k1[j],
                                diff_lambda_q2[j], diff_lambda_k2[j], diff_subln[j],
                                diff_w_o[j], lambda_init)
        h = h + rms_norm(m, norms[i, 1])
        f = conv_glu_ffn(rms_norm(h, norms[i, 2]), ffn_w_up[i], ffn_conv[i], ffn_w_down[i])
        h = h + rms_norm(f, norms[i, 3])
    return h[:, N_META:]
```

```cpp
#include <hip/hip_runtime.h>
#include <hip/hip_cooperative_groups.h>
#include <cstdio>
#include <cstdint>
namespace cg = cooperative_groups;

#ifndef MK_MULTI
#define MK_MULTI 0
#endif

namespace pg8 {
#define PG8_LAS __attribute__((address_space(3)))
typedef unsigned short bf16_t;
typedef short bf16x8 __attribute__((ext_vector_type(8)));
typedef float f32x4 __attribute__((ext_vector_type(4)));
typedef unsigned u32x4 __attribute__((ext_vector_type(4)));
typedef unsigned u32x2 __attribute__((ext_vector_type(2)));
constexpr int BM = 256, BK = 64, HALF = 128, HTB = HALF * BK * 2  , STAGE_BYTES = 8 * HTB, NXCD = 8, WGM = 8;

__host__ __device__ __forceinline__ int lds_byte(int r, int c) { const int st = (r >> 4) * 2 + (c >> 5), rr = r & 15, cc = c & 31, ob = rr * 64 + cc * 2; return st * 1024 + (ob ^ (((ob >> 9) & 1) << 5)); }
__host__ __device__ __forceinline__ void stage_rc(int b, int& R, int& C) { const int st = b / 1024, sb = b % 1024, swz = sb ^ (((sb >> 9) & 1) << 5); R = (st >> 1) * 16 + swz / 64; C = (st & 1) * 32 + (swz % 64) / 2; }
__host__ __device__ __forceinline__ int perm32(int rho) { const int n = rho >> 4, i = rho & 15; return 8 * (i >> 2) + 4 * n + (i & 3); }

struct Unit { int pm, pn; };
struct Gemm { const bf16_t* A; const bf16_t* Bt; int K; };

struct StaticOrder {
    int nM, nN, nwg, G, c;
    __host__ __device__ void init(int nM_, int nN_, int G_, int c_) { nM = nM_; nN = nN_; nwg = nM * nN; G = G_; c = c_; }
    __host__ __device__ bool next(int i, Unit& u) const {
        const long L = (long)i * G + c; if (L >= nwg) return false;
        int wgid = (int)L; { const int q = nwg / NXCD, r = nwg % NXCD, xcd = wgid % NXCD, off = wgid / NXCD; wgid = (xcd < r ? xcd * (q + 1) : r * (q + 1) + (xcd - r) * q) + off; }
        const int nig = WGM * nN, gid = wgid / nig, fm = gid * WGM, gsz = (nM - fm) < WGM ? (nM - fm) : WGM;
        u.pm = fm + ((wgid % nig) % gsz); u.pn = (wgid % nig) / gsz; return true;
    }
};

__device__ __forceinline__ unsigned cvt_pk_bf16(float lo, float hi) { unsigned r; asm volatile("v_cvt_pk_bf16_f32 %0, %1, %2" : "=v"(r) : "v"(lo), "v"(hi)); return r; }

struct EpiBf16 {
    static constexpr bool PERM = true;
    bf16_t* O; int ldc;
    __device__ __forceinline__ void operator()(const f32x4 (&acc)[2][2][4][2], const Unit& u, int wr, int wc, int fr, int fq) const {
        const int row0 = u.pm * BM + wr * 64 + fr; const int col0 = u.pn * BM + wc * 32 + 8 * fq;
#pragma unroll
        for (int ai = 0; ai < 2; ++ai)
#pragma unroll
            for (int m = 0; m < 4; ++m) { bf16_t* rowp = O + (size_t)(row0 + ai * HALF + m * 16) * ldc + col0;
#pragma unroll
                for (int bj = 0; bj < 2; ++bj) { const f32x4 v0 = acc[ai][bj][m][0], v1 = acc[ai][bj][m][1];
                    u32x4 w; w.x = cvt_pk_bf16(v0[0], v0[1]); w.y = cvt_pk_bf16(v0[2], v0[3]); w.z = cvt_pk_bf16(v1[0], v1[1]); w.w = cvt_pk_bf16(v1[2], v1[3]);
                    *(u32x4*)(rowp + bj * HALF) = w; } }
    }
};
template <class Epi, class Sched, bool AOV = false>
__device__ __forceinline__ void gemm_phase(PG8_LAS unsigned char* lds, const Gemm g, const Sched& S, const Epi& E, int tid_in) {
    int tid_ = tid_in; asm volatile("" : "+v"(tid_));
    const int tid = tid_, wid = __builtin_amdgcn_readfirstlane(tid >> 6), lane = tid & 63, wr = wid >> 2, wc = wid & 3, fr = lane & 15, fq = lane >> 4;
    const int K = g.K, nt = K / BK;
    unsigned voffA[2], voffB[2];
#pragma unroll
    for (int i = 0; i < 2; ++i) { int R, C; stage_rc(tid * 16 + i * 8192, R, C); const int Rb = Epi::PERM ? ((R & ~31) + perm32(R & 31)) : R;
        voffA[i] = (unsigned)((AOV ? (R - 2 * (R >> 6)) : R) * K + C) * 2u; voffB[i] = (unsigned)(Rb * K + C) * 2u; }
    const size_t kstep = (size_t)(BK * 2);
    const size_t hstepB = (size_t)HALF * K * 2, hstepA = (size_t)(AOV ? 124 : HALF) * K * 2;
    const size_t tstepA = 2 * hstepA, tstepB = 2 * hstepB;
    const unsigned ldsw = (unsigned)wid * 1024u;
    const int aoff = lds_byte(wr * 64 + fr, fq * 8), boff = lds_byte(wc * 32 + fr, fq * 8);
#define PG8_SA(b, h) (((b) * 2 + (h)) * HTB)
#define PG8_SB(b, h) ((4 + (b) * 2 + (h)) * HTB)
#define PG8_STAGE(bufoff, gbase, voff) do { _Pragma("unroll") for (int _i = 0; _i < 2; ++_i) \
        __builtin_amdgcn_global_load_lds((const unsigned*)((const char*)(gbase) + (voff)[_i]), (PG8_LAS unsigned*)(lds + (bufoff) + ldsw + _i * 8192), 16, 0, 0); } while (0)
#define PG8_LDA(dst, b, h) do { _Pragma("unroll") for (int m = 0; m < 4; ++m) _Pragma("unroll") for (int k = 0; k < 2; ++k) dst[m][k] = *(const PG8_LAS bf16x8*)(lds + PG8_SA(b, h) + aoff + m * 2048 + k * 1024); } while (0)
#define PG8_LDB(dst, b, h) do { _Pragma("unroll") for (int n = 0; n < 2; ++n) _Pragma("unroll") for (int k = 0; k < 2; ++k) dst[n][k] = *(const PG8_LAS bf16x8*)(lds + PG8_SB(b, h) + boff + n * 2048 + k * 1024); } while (0)
#define PG8_MMA(ai, bj, At, Bt) do { __builtin_amdgcn_s_setprio(1); _Pragma("unroll") for (int m = 0; m < 4; ++m) _Pragma("unroll") for (int n = 0; n < 2; ++n) _Pragma("unroll") for (int k = 0; k < 2; ++k) \
        acc[ai][bj][m][n] = __builtin_amdgcn_mfma_f32_16x16x32_bf16(Bt[n][k], At[m][k], acc[ai][bj][m][n], 0, 0, 0); __builtin_amdgcn_s_setprio(0); } while (0)
#define PG8_WAIT_V(n) asm volatile("s_waitcnt vmcnt(" #n ")" ::: "memory")
#define PG8_WAIT_L(n) asm volatile("s_waitcnt lgkmcnt(" #n ")" ::: "memory")
#define PG8_BAR __builtin_amdgcn_s_barrier()
#define PG8_SCHED __builtin_amdgcn_sched_barrier(0)
    Unit cur, nxt; int ui = 0;
    if (!S.next(0, cur)) return;
    f32x4 acc[2][2][4][2];
#pragma unroll
    for (int a = 0; a < 2; ++a)
#pragma unroll
        for (int b = 0; b < 2; ++b)
#pragma unroll
            for (int m = 0; m < 4; ++m)
#pragma unroll
                for (int n = 0; n < 2; ++n) acc[a][b][m][n] = (f32x4){0.f, 0.f, 0.f, 0.f};
    bf16x8 At[4][2], B0[2][2], B1[2][2];
    const char* cA = (const char*)g.A + (size_t)cur.pm * tstepA; const char* cB = (const char*)g.Bt + (size_t)cur.pn * tstepB;
    PG8_STAGE(PG8_SB(0, 0), cB, voffB); PG8_STAGE(PG8_SA(0, 0), cA, voffA); PG8_STAGE(PG8_SB(0, 1), cB + hstepB, voffB); PG8_STAGE(PG8_SA(0, 1), cA + hstepA, voffA);
    if (wr == 1) PG8_BAR;
    PG8_WAIT_V(4); PG8_BAR;
    PG8_STAGE(PG8_SB(1, 0), cB + kstep, voffB); PG8_STAGE(PG8_SA(1, 0), cA + kstep, voffA); PG8_STAGE(PG8_SB(1, 1), cB + hstepB + kstep, voffB);
    PG8_WAIT_V(6); PG8_BAR;
    for (;;) {
        const bool has_next = S.next(ui + 1, nxt);
        const char* nA = has_next ? (const char*)g.A + (size_t)nxt.pm * tstepA : cA; const char* nB = has_next ? (const char*)g.Bt + (size_t)nxt.pn * tstepB : cB;
        for (int t = 0; t < nt; t += 2) {
            const bool last = (t == nt - 2);
            const char* a1 = cA + (size_t)(t + 1) * kstep;
            const char* a2 = last ? nA : cA + (size_t)(t + 2) * kstep; const char* b2 = last ? nB : cB + (size_t)(t + 2) * kstep;
            const char* a3 = a2 + kstep; const char* b3 = b2 + kstep;
            PG8_LDB(B0, 0, 0); PG8_SCHED; PG8_LDA(At, 0, 0); PG8_STAGE(PG8_SA(1, 1), a1 + hstepA, voffA);
            PG8_WAIT_L(8); PG8_BAR; PG8_WAIT_L(0); PG8_MMA(0, 0, At, B0); PG8_BAR; PG8_SCHED;
            PG8_LDB(B1, 0, 1); PG8_STAGE(PG8_SB(0, 0), b2, voffB);
            PG8_BAR; PG8_WAIT_L(0); PG8_MMA(0, 1, At, B1); PG8_BAR;
            PG8_LDA(At, 0, 1); PG8_STAGE(PG8_SA(0, 0), a2, voffA);
            PG8_BAR; PG8_WAIT_L(0); PG8_MMA(1, 0, At, B0); PG8_BAR; PG8_SCHED;
            PG8_STAGE(PG8_SB(0, 1), b2 + hstepB, voffB);
            PG8_WAIT_V(6); PG8_BAR; PG8_MMA(1, 1, At, B1); PG8_BAR;
            PG8_LDB(B0, 1, 0); PG8_SCHED; PG8_LDA(At, 1, 0); PG8_STAGE(PG8_SA(0, 1), a2 + hstepA, voffA);
            PG8_WAIT_L(8); PG8_BAR; PG8_WAIT_L(0); PG8_MMA(0, 0, At, B0); PG8_BAR; PG8_SCHED;
            PG8_LDB(B1, 1, 1); PG8_STAGE(PG8_SB(1, 0), b3, voffB);
            PG8_BAR; PG8_WAIT_L(0); PG8_MMA(0, 1, At, B1); PG8_BAR;
            PG8_LDA(At, 1, 1); PG8_STAGE(PG8_SA(1, 0), a3, voffA);
            PG8_BAR; PG8_WAIT_L(0); PG8_MMA(1, 0, At, B0); PG8_BAR; PG8_SCHED;
            PG8_STAGE(PG8_SB(1, 1), b3 + hstepB, voffB);
            PG8_WAIT_V(6); PG8_BAR; PG8_MMA(1, 1, At, B1); PG8_BAR;
        }
        E(acc, cur, wr, wc, fr, fq);
        if (!has_next) break;
#pragma unroll
        for (int a = 0; a < 2; ++a)
#pragma unroll
            for (int b = 0; b < 2; ++b)
#pragma unroll
                for (int m = 0; m < 4; ++m)
#pragma unroll
                    for (int n = 0; n < 2; ++n) acc[a][b][m][n] = (f32x4){0.f, 0.f, 0.f, 0.f};
        cur = nxt; cA = nA; cB = nB; ++ui;
    }
    PG8_WAIT_V(0);
    if (wr == 0) PG8_BAR;
    PG8_BAR;
#undef PG8_SA
#undef PG8_SB
#undef PG8_STAGE
#undef PG8_LDA
#undef PG8_LDB
#undef PG8_MMA
#undef PG8_WAIT_V
#undef PG8_WAIT_L
#undef PG8_BAR
#undef PG8_SCHED
}
}


namespace pg8 {
constexpr int SEQ_L = 4112;
template <int CTRL> __device__ __forceinline__ float dppf(float v) { return __builtin_bit_cast(float, __builtin_amdgcn_update_dpp(0, __builtin_bit_cast(int, v), CTRL, 0xf, 0xf, true)); }
template <int CTRL> __device__ __forceinline__ float dppo(float old, float v) { return __builtin_bit_cast(float, __builtin_amdgcn_update_dpp(__builtin_bit_cast(int, old), __builtin_bit_cast(int, v), CTRL, 0xf, 0xf, false)); }
__device__ __forceinline__ unsigned f2bf(float f) { unsigned u = __builtin_bit_cast(unsigned, f); return (u + 0x7fffu + ((u >> 16) & 1u)) >> 16; }
typedef float f32x2_t __attribute__((ext_vector_type(2))); typedef __bf16 bf16x2_t __attribute__((ext_vector_type(2)));
__device__ __forceinline__ unsigned pk2(float lo, float hi) { f32x2_t v = {lo, hi}; bf16x2_t b = __builtin_convertvector(v, bf16x2_t); return __builtin_bit_cast(unsigned, b); }

constexpr float QK_SCALE_L2E = 0.10206207261596577f * 1.4426950408889634f;
struct EpiMlaQ {
    static constexpr bool PERM = false;
    bf16_t* Q; const float* rope;
    __device__ __forceinline__ void operator()(const f32x4 (&acc)[2][2][4][2], const Unit& u, int wr, int wc, int fr, int fq) const {
#pragma unroll
        for (int ai = 0; ai < 2; ++ai)
#pragma unroll
            for (int m = 0; m < 4; ++m) {
                const int row = u.pm * BM + ai * HALF + wr * 64 + m * 16 + fr;
                const int t = row % SEQ_L;
                const f32x4 cs = *(const f32x4*)(rope + t * 32 + 4 * fq), sn = *(const f32x4*)(rope + t * 32 + 16 + 4 * fq);
#pragma unroll
                for (int bj = 0; bj < 2; ++bj) {
                    const int c32 = u.pn * BM + bj * HALF + wc * 32;
                    f32x4 v0 = acc[ai][bj][m][0], v1 = acc[ai][bj][m][1];
                    if (((c32 >> 5) % 3) == 2) { const f32x4 x1 = v0, x2 = v1; v0 = x1 * cs - x2 * sn; v1 = x2 * cs + x1 * sn; }
                    v0 *= QK_SCALE_L2E; v1 *= QK_SCALE_L2E;
                    bf16_t* p = Q + (size_t)row * 1536 + c32 + 4 * fq;
                    u32x2 w0, w1; w0.x = pk2(v0[0], v0[1]); w0.y = pk2(v0[2], v0[3]); w1.x = pk2(v1[0], v1[1]); w1.y = pk2(v1[2], v1[3]);
                    *(u32x2*)p = w0; *(u32x2*)(p + 16) = w1;
                }
                asm volatile("" ::: "memory");
            }
    }
};
struct EpiMlaKV {
    static constexpr bool PERM = false;
    bf16_t* Kb; bf16_t* Vb;
    __device__ __forceinline__ void operator()(const f32x4 (&acc)[2][2][4][2], const Unit& u, int wr, int wc, int fr, int fq) const {
#pragma unroll
        for (int ai = 0; ai < 2; ++ai)
#pragma unroll
            for (int m = 0; m < 4; ++m) {
                const int row = u.pm * BM + ai * HALF + wr * 64 + m * 16 + fr;
#pragma unroll
                for (int bj = 0; bj < 2; ++bj) {
                    const int head = u.pn * 2 + bj;
                    bf16_t* p = (wc < 2) ? (Kb + (size_t)row * 1536 + head * 96 + wc * 32 + 4 * fq) : (Vb + (size_t)row * 1024 + head * 64 + (wc - 2) * 32 + 4 * fq);
                    const f32x4 v0 = acc[ai][bj][m][0], v1 = acc[ai][bj][m][1];
                    u32x2 w0, w1; w0.x = pk2(v0[0], v0[1]); w0.y = pk2(v0[2], v0[3]); w1.x = pk2(v1[0], v1[1]); w1.y = pk2(v1[2], v1[3]);
                    *(u32x2*)p = w0; *(u32x2*)(p + 16) = w1;
                }
            }
    }
};
struct EpiFfnUp {
    static constexpr bool PERM = false;
    bf16_t* ACT; const float* cw; int Mrows;
    __device__ __forceinline__ void operator()(const f32x4 (&acc)[2][2][4][2], const Unit& u, int wr, int wc, int fr, int fq) const {
#pragma unroll
        for (int n = 0; n < 2; ++n) {
            const int col = u.pn * 128 + wc * 32 + n * 16 + 4 * fq;
            const f32x4 g0 = *(const f32x4*)(cw + col), g1 = *(const f32x4*)(cw + 5632 + col), g2 = *(const f32x4*)(cw + 2 * 5632 + col);
            const f32x4 u0 = *(const f32x4*)(cw + 2816 + col), u1 = *(const f32x4*)(cw + 5632 + 2816 + col), u2 = *(const f32x4*)(cw + 2 * 5632 + 2816 + col);
#pragma unroll
            for (int ai = 0; ai < 2; ++ai)
#pragma unroll
                for (int m = 0; m < 4; ++m) {
                    const int grow = u.pm * 248 + ai * 124 + wr * 62 + m * 16 + fr - 2;
                    const int t = (grow + SEQ_L) % SEQ_L;
                    const bool ok = (m * 16 + fr >= 2) && grow < Mrows;
                    const bool edge = __any(t <= 1);
                    float r[4];
#pragma unroll
                    for (int j = 0; j < 4; ++j) {
                        const float gc = acc[ai][0][m][n][j], uc = acc[ai][1][m][n][j];
                        float go1 = 0.f, go2 = 0.f, uo1 = 0.f, uo2 = 0.f;
                        if (m > 0) { const float gq = acc[ai][0][m - 1][n][j], uq = acc[ai][1][m - 1][n][j];
                            go1 = dppf<0x10F>(gq); go2 = dppf<0x10E>(gq); uo1 = dppf<0x10F>(uq); uo2 = dppf<0x10E>(uq); }
                        float gp1 = dppo<0x111>(go1, gc), gp2 = dppo<0x112>(go2, gc), up1 = dppo<0x111>(uo1, uc), up2 = dppo<0x112>(uo2, uc);
                        if (edge) { if (t == 0) { gp1 = 0.f; up1 = 0.f; } if (t <= 1) { gp2 = 0.f; up2 = 0.f; } }
                        const float G = g2[j] * gc + g1[j] * gp1 + g0[j] * gp2;
                        const float U = u2[j] * uc + u1[j] * up1 + u0[j] * up2;
                        r[j] = G * U * __builtin_amdgcn_rcpf(1.f + __builtin_amdgcn_exp2f(-1.4426950408889634f * G));
                    }
                    if (ok) { u32x2 w; w.x = pk2(r[0], r[1]); w.y = pk2(r[2], r[3]); *(u32x2*)(ACT + (size_t)grow * 2816 + col) = w; }
                }
        }
    }
};
}

#define LAS __attribute__((address_space(3)))
typedef unsigned short bf16_t;
typedef short bf16x8 __attribute__((ext_vector_type(8)));
typedef short s16x4 __attribute__((ext_vector_type(4)));
typedef float f32x4 __attribute__((ext_vector_type(4)));
typedef float f32x16 __attribute__((ext_vector_type(16)));
typedef unsigned u32x4 __attribute__((ext_vector_type(4)));
typedef unsigned u32x2 __attribute__((ext_vector_type(2)));
using pg8::pk2;

constexpr int NW = 8, NT_BLK = NW * 64;
constexpr int DM = 1024, NB = 8, SEQ = 4096, NMETA = 16, SL = 4112, MROWS = NB * SL  , MP = 33024  , FF = 2816, DEPTH = 4;
constexpr float EPS = 1e-6f;
static_assert(SL == pg8::SEQ_L, "seq");
constexpr int NM = MP / 256;
constexpr int NM_UP = 133;

constexpr size_t MiB = 1u << 20;
constexpr size_t WS_ROPE = 1 * MiB;
constexpr size_t WS_HM = 2 * MiB;
constexpr size_t WS_W = 4 * MiB;
constexpr size_t WS_XN = 97 * MiB;
constexpr size_t ROWB = (size_t)MP * 2048;
constexpr size_t WS_MO = WS_XN + ROWB;
constexpr size_t WS_R = WS_MO + ROWB;
constexpr size_t WS_END = WS_R + 230 * MiB;
constexpr size_t W_MLA_IN = 0, SZ_MLA_IN = 512 * 1024;
constexpr size_t W_MLA_UQ = W_MLA_IN + 2 * SZ_MLA_IN, SZ_MLA_UQ = 1536 * 256;
constexpr size_t W_MLA_UKV = W_MLA_UQ + 2 * SZ_MLA_UQ, SZ_MLA_UKV = 2048 * 256;
constexpr size_t W_MLA_O = W_MLA_UKV + 2 * SZ_MLA_UKV, SZ_SQ = 1024 * 1024;
constexpr size_t W_SC_IN = W_MLA_O + 2 * SZ_SQ, SZ_3D = 3072 * 1024;
constexpr size_t W_SC_OUT = W_SC_IN + SZ_3D;
constexpr size_t W_DF_IN = W_SC_OUT + SZ_SQ;
constexpr size_t W_DF_O = W_DF_IN + SZ_3D;
constexpr size_t W_UP = W_DF_O + SZ_SQ, SZ_UP = 5632 * 1024;
constexpr size_t W_DN = W_UP + 4 * SZ_UP, SZ_DN = 1024 * 2816;
constexpr size_t W_TOTAL = W_DN + 4 * SZ_DN;
static_assert(WS_W + W_TOTAL * 2 + 8192 <= WS_XN, "weights fit");
constexpr size_t R_NQ = 0, R_NKV = 17 * MiB, R_Q = 34 * MiB, R_C = 34 * MiB, R_K = 131 * MiB;
static_assert(R_K + (size_t)MP * 1536 * 2 <= 230 * MiB && R_Q + (size_t)MP * 1536 * 2 <= R_K && (size_t)MP * 3072 * 2 <= 230 * MiB, "R map");

constexpr int LDS_BYTES = 131072 + 1024;

struct Args { const float* in[22]; float* out; unsigned char* ws; int ph_lo, ph_hi; };

#define GASP __attribute__((address_space(1)))
#define INP(i) ld_inp<(i)>()
template <int I> __device__ __forceinline__ const float* ld_inp() {
    unsigned long long v; asm volatile("s_load_dwordx2 %0, %1, %2\n\ts_waitcnt lgkmcnt(0)" : "=s"(v) : "s"(__builtin_amdgcn_kernarg_segment_ptr()), "i"(I * 8));
    return (const float*)(GASP const float*)v;
}
__device__ __forceinline__ float lane_xor(float v, int lane, int o) { return __builtin_bit_cast(float, __builtin_amdgcn_ds_bpermute((lane ^ o) << 2, __builtin_bit_cast(int, v))); }
__device__ __forceinline__ float wave_sum(float v, int lane) {
#pragma unroll
    for (int o = 1; o < 64; o <<= 1) v += lane_xor(v, lane, o);
    return v;
}
__device__ __forceinline__ float bf2f(unsigned short b) { return __builtin_bit_cast(float, (unsigned)b << 16); }
__device__ __forceinline__ float bflo(unsigned w) { return __builtin_bit_cast(float, w << 16); }
__device__ __forceinline__ float bfhi(unsigned w) { return __builtin_bit_cast(float, w & 0xffff0000u); }
__device__ __forceinline__ float* hrow(float* out, float* hm, int m) {
    const int b = m / SL, t = m - b * SL;
    return t < NMETA ? hm + (size_t)(b * NMETA + t) * DM : out + ((size_t)b * SEQ + (t - NMETA)) * DM;
}

__device__ __forceinline__ void cvt_weight(const float* W, int Ks, int Ns, bf16_t* WT, int Kd, int Nd, int mode, LAS float* scr, int gw, int NGW, int lane, int& base) {
    const int nblk = Nd / 32, nitems = (Kd / 64) * nblk;
    int first = (gw - base) % NGW; if (first < 0) first += NGW;
    base = (base + nitems) % NGW;
    for (int it = first; it < nitems; it += NGW) {
        const int kb = it / nblk, nb = it - kb * nblk, k0 = 64 * kb, p0 = 32 * nb;
        int lc = p0;
        if (mode == 1) { const int pn = p0 >> 8, j = p0 & 255; lc = (j < 128) ? 128 * pn + j : FF + 128 * pn + (j - 128); }
        const bool zero = (lc >= Ns) || (k0 >= Ks);
        { f32x4 v[8];
#pragma unroll
          for (int i = 0; i < 8; ++i) { const int kk = 8 * i + (lane >> 3); v[i] = zero ? (f32x4){0.f, 0.f, 0.f, 0.f} : *(const f32x4*)(W + (size_t)(k0 + kk) * Ns + lc + 4 * (lane & 7)); }
#pragma unroll
          for (int i = 0; i < 8; ++i) { const int kk = 8 * i + (lane >> 3); LAS float* d = scr + kk * 33 + 4 * (lane & 7); d[0] = v[i].x; d[1] = v[i].y; d[2] = v[i].z; d[3] = v[i].w; } }
        asm volatile("s_waitcnt lgkmcnt(0)" ::: "memory");
        const int c = lane & 7;
#pragma unroll
        for (int j = 0; j < 4; ++j) { const int n = (lane >> 3) + 8 * j; const LAS float* s = scr + (8 * c) * 33 + n;
            u32x4 o; o.x = pk2(s[0 * 33], s[1 * 33]); o.y = pk2(s[2 * 33], s[3 * 33]); o.z = pk2(s[4 * 33], s[5 * 33]); o.w = pk2(s[6 * 33], s[7 * 33]);
            *(u32x4*)(WT + (size_t)(p0 + n) * Kd + k0 + 8 * c) = o; }
        asm volatile("s_waitcnt lgkmcnt(0)" ::: "memory");
    }
}

__device__ __forceinline__ void rms_store_bf16(const f32x4 (&v)[4], const float* g, bf16_t* orow, int lane) {
    float s = 0.f;
#pragma unroll
    for (int j = 0; j < 4; ++j) s += (v[j].x * v[j].x + v[j].y * v[j].y) + (v[j].z * v[j].z + v[j].w * v[j].w);
    const float r = rsqrtf(wave_sum(s, lane) * (1.f / DM) + EPS);
#pragma unroll
    for (int j = 0; j < 4; ++j) { const f32x4 gg = *(const f32x4*)(g + 4 * lane + 256 * j);
        u32x2 w; w.x = pk2(v[j].x * r * gg.x, v[j].y * r * gg.y); w.y = pk2(v[j].z * r * gg.z, v[j].w * r * gg.w);
        *(u32x2*)(orow + 4 * lane + 256 * j) = w; }
}

__device__ __forceinline__ s16x4 vtr(const LAS unsigned char* p) { typedef short v4i16_t __attribute__((ext_vector_type(4)));
    return __builtin_bit_cast(s16x4, __builtin_amdgcn_ds_read_tr16_b64_v4i16((LAS v4i16_t*)p)); }
__device__ __forceinline__ int crow(int r, int hi) { return (r & 3) + 8 * (r >> 2) + 4 * hi; }
__device__ __forceinline__ float xhalf_max(float m) { auto rr = __builtin_amdgcn_permlane32_swap(__float_as_uint(m), __float_as_uint(m), false, false); return fmaxf(__uint_as_float(rr[0]), __uint_as_float(rr[1])); }
__device__ __forceinline__ float xhalf_sum(float m) { auto rr = __builtin_amdgcn_permlane32_swap(__float_as_uint(m), __float_as_uint(m), false, false); return __uint_as_float(rr[0]) + __uint_as_float(rr[1]); }

template <int DQK, int DV, bool ALIBI, bool DUAL = false, bool FAST = false>
__device__ __forceinline__ void attn_unit(LAS unsigned char* lds, const bf16_t* Qh, int qpitch, const bf16_t* Kh, int kpitch, const bf16_t* Vh, int vpitch, bf16_t* Oh, int opitch,
                                          int q_lo, int q_hi, float c1, float c2, int tid_in, float lam = 0.f, const float* gsub = nullptr, float oscale = 1.f) {
    constexpr int KW = DUAL ? 2 * DQK : DQK;
    constexpr int KP = KW * 2 + 16, VP = DV * 2 + 64, KBYTES = 64 * KP, VBYTES = 64 * VP, BUF = KBYTES + VBYTES;
    constexpr int KCH = KW / 8, VCH = DV / 8, NKC = 64 * KCH, NVC = 64 * VCH, KPT = (NKC + NT_BLK - 1) / NT_BLK, VPT = (NVC + NT_BLK - 1) / NT_BLK;
    static_assert(2 * KBYTES + 3 * VBYTES <= 131072, "attention LDS");
    int tid_ = tid_in; asm volatile("" : "+v"(tid_));
    const int tid = tid_, lane = tid & 63, r32 = lane & 31, hi = lane >> 5; const int wid = __builtin_amdgcn_readfirstlane(tid >> 6);
    const int mapi = DUAL ? (wid >> 2) : 0;
    const int wq0 = q_lo + 32 * (DUAL ? (wid & 3) : wid), qpos = wq0 + r32;
    const int NT = (q_hi + 63) >> 6;
    const int wlast = (wq0 < q_hi) ? ((((wq0 + 31) < (q_hi - 1)) ? (wq0 + 31) : (q_hi - 1)) >> 6) : -1;
    bf16x8 qf[DQK / 16];
    { const int qrow = qpos < SL ? qpos : SL - 1;
#pragma unroll
      for (int st = 0; st < DQK / 16; ++st) { qf[st] = *(const bf16x8*)(Qh + (size_t)qrow * qpitch + mapi * DQK + 16 * st + 8 * hi);
          if (FAST && ALIBI) {
              u32x4 w = __builtin_bit_cast(u32x4, qf[st]);
#pragma unroll
              for (int e = 0; e < 4; ++e) w[e] = pk2(bflo(w[e]) * c1, bfhi(w[e]) * c1);
              qf[st] = __builtin_bit_cast(bf16x8, w); } } }
    f32x16 o[DV / 32];
#pragma unroll
    for (int d = 0; d < DV / 32; ++d) o[d] = f32x16{};
    float mrun = FAST ? 0.f : -INFINITY, lrun = 0.f;
    f32x16 negm = f32x16{}, osum = f32x16{};
    const bf16x8 ones8 = (bf16x8){0x3F80, 0x3F80, 0x3F80, 0x3F80, 0x3F80, 0x3F80, 0x3F80, 0x3F80};
    u32x4 kreg[2][KPT], vreg[2][VPT];
#define AT_LOAD(t, S) do { \
    _Pragma("unroll") for (int i_ = 0; i_ < KPT; ++i_) { const int c_ = tid + NT_BLK * i_; if (c_ < NKC) { const int key_ = c_ / KCH, ch_ = c_ - key_ * KCH; kreg[S][i_] = *(const u32x4*)(Kh + (size_t)((t) * 64 + key_) * kpitch + ch_ * 8); } } \
    _Pragma("unroll") for (int i_ = 0; i_ < VPT; ++i_) { const int c_ = tid + NT_BLK * i_; if (c_ < NVC) { const int key_ = c_ / VCH, ch_ = c_ - key_ * VCH; vreg[S][i_] = *(const u32x4*)(Vh + (size_t)((t) * 64 + key_) * vpitch + ch_ * 8); } } } while (0)
#define AT_STORE(kb, vs, S) do { \
    _Pragma("unroll") for (int i_ = 0; i_ < KPT; ++i_) { const int c_ = tid + NT_BLK * i_; if (c_ < NKC) { const int key_ = c_ / KCH, ch_ = c_ - key_ * KCH; *(LAS u32x4*)(lds + (kb) * KBYTES + key_ * KP + ch_ * 16) = kreg[S][i_]; } } \
    _Pragma("unroll") for (int i_ = 0; i_ < VPT; ++i_) { const int c_ = tid + NT_BLK * i_; if (c_ < NVC) { const int key_ = c_ / VCH, ch_ = c_ - key_ * VCH; *(LAS u32x4*)(lds + 2 * KBYTES + (vs) * VBYTES + key_ * VP + ch_ * 16) = vreg[S][i_]; } } } while (0)
    const bool late = wid >= 4;
    AT_LOAD(0, 0); AT_STORE(0, 0, 0);
    if (1 < NT) AT_LOAD(1, 1);
    __syncthreads();
    const int vb = (4 * hi + ((lane & 15) >> 2)) * VP + (16 * ((lane >> 4) & 1) + 4 * (lane & 3)) * 2;
    bf16x8 pb[4];
#define AT_PV(vslot) do { const LAS unsigned char* vb_ = lds + 2 * KBYTES + (vslot) * VBYTES + vb; \
    _Pragma("unroll") for (int d = 0; d < DV / 32; ++d) _Pragma("unroll") for (int ks = 0; ks < 4; ++ks) { \
        const s16x4 lo_ = vtr(vb_ + (16 * ks) * VP + 64 * d), up_ = vtr(vb_ + (16 * ks + 8) * VP + 64 * d); \
        const bf16x8 a_ = (bf16x8){lo_[0], lo_[1], lo_[2], lo_[3], up_[0], up_[1], up_[2], up_[3]}; \
        o[d] = __builtin_amdgcn_mfma_f32_32x32x16_bf16(a_, pb[ks], o[d], 0, 0, 0); } \
    if (FAST) { _Pragma("unroll") for (int ks = 0; ks < 4; ++ks) osum = __builtin_amdgcn_mfma_f32_32x32x16_bf16(ones8, pb[ks], osum, 0, 0, 0); } } while (0)
    int vprev = 0, vcur = 0, vnext = 1;
    for (int t2 = 0; t2 < NT; t2 += 2) {
#pragma unroll
    for (int par = 0; par < 2; ++par) {
        const int t = t2 + par; if (t >= NT) break;
        const int buf = par;
        if (t + 2 < NT) AT_LOAD(t + 2, par);
        if (late && t >= 1 && t - 1 <= wlast) AT_PV(vprev);
        if (t <= wlast) {
            const LAS unsigned char* kb_ = lds + buf * KBYTES + r32 * KP + 16 * hi + mapi * (DQK * 2);
            f32x16 s0 = FAST ? negm : f32x16{}, s1 = FAST ? negm : f32x16{};
#pragma unroll
            for (int st = 0; st < DQK / 16; ++st) {
                const bf16x8 a0 = *(const LAS bf16x8*)(kb_ + 32 * st), a1 = *(const LAS bf16x8*)(kb_ + 32 * KP + 32 * st);
                s0 = __builtin_amdgcn_mfma_f32_32x32x16_bf16(a0, qf[st], s0, 0, 0, 0);
                s1 = __builtin_amdgcn_mfma_f32_32x32x16_bf16(a1, qf[st], s1, 0, 0, 0);
            }
            const int kbase = t * 64 + 4 * hi - qpos;
            if (ALIBI) {
                const float b0 = c2 * (float)kbase;
#pragma unroll
                for (int r = 0; r < 16; ++r) { const float kr = (float)((r & 3) + 8 * (r >> 2));
                    if (FAST) { s0[r] += fmaf(c2, kr, b0); s1[r] += fmaf(c2, kr + 32.f, b0); }
                    else { s0[r] = fmaf(s0[r], c1, fmaf(c2, kr, b0)); s1[r] = fmaf(s1[r], c1, fmaf(c2, kr + 32.f, b0)); } }
            }
            if (t * 64 + 63 > wq0) {
#pragma unroll
                for (int r = 0; r < 16; ++r) { const int dk = kbase + (r & 3) + 8 * (r >> 2); if (dk > 0) s0[r] = -INFINITY; if (dk + 32 > 0) s1[r] = -INFINITY; }
            }
            float mx = fmaxf(s0[0], s1[0]);
#pragma unroll
            for (int r = 1; r < 16; ++r) mx = fmaxf(fmaxf(mx, s0[r]), s1[r]);
            mx = xhalf_max(mx);
            if (FAST) {
                if (t == 0 || __any(mx > 8.f)) {
                    const float dl = (t == 0) ? mx : fmaxf(mx, 0.f);
                    mrun += dl;
#pragma unroll
                    for (int r = 0; r < 16; ++r) { s0[r] -= dl; s1[r] -= dl; negm[r] = -mrun; }
                    if (t != 0) { const float f = __builtin_amdgcn_exp2f(-dl);
#pragma unroll
                        for (int r = 0; r < 16; ++r) osum[r] *= f;
#pragma unroll
                        for (int d = 0; d < DV / 32; ++d)
#pragma unroll
                            for (int r = 0; r < 16; ++r) o[d][r] *= f; }
                }
#pragma unroll
                for (int r = 0; r < 16; ++r) { s0[r] = __builtin_amdgcn_exp2f(s0[r]); s1[r] = __builtin_amdgcn_exp2f(s1[r]); }
            } else {
            if (!ALIBI) mx *= c1;
            const float mn = fmaxf(mrun, mx);
            if (__any(mn != mrun)) {
                const float alpha = __builtin_amdgcn_exp2f(mrun - mn);
                lrun *= alpha;
#pragma unroll
                for (int d = 0; d < DV / 32; ++d)
#pragma unroll
                    for (int r = 0; r < 16; ++r) o[d][r] *= alpha;
                mrun = mn;
            }
            float ps = 0.f;
#pragma unroll
            for (int r = 0; r < 16; ++r) {
                if (ALIBI) { s0[r] = __builtin_amdgcn_exp2f(s0[r] - mn); s1[r] = __builtin_amdgcn_exp2f(s1[r] - mn); }
                else { s0[r] = __builtin_amdgcn_exp2f(fmaf(s0[r], c1, -mn)); s1[r] = __builtin_amdgcn_exp2f(fmaf(s1[r], c1, -mn)); }
                ps += s0[r] + s1[r]; }
            lrun += ps;
            }
            { u32x4 w;
              w.x = pk2(s0[0], s0[1]); w.y = pk2(s0[2], s0[3]); w.z = pk2(s0[4], s0[5]); w.w = pk2(s0[6], s0[7]); pb[0] = __builtin_bit_cast(bf16x8, w);
              w.x = pk2(s0[8], s0[9]); w.y = pk2(s0[10], s0[11]); w.z = pk2(s0[12], s0[13]); w.w = pk2(s0[14], s0[15]); pb[1] = __builtin_bit_cast(bf16x8, w);
              w.x = pk2(s1[0], s1[1]); w.y = pk2(s1[2], s1[3]); w.z = pk2(s1[4], s1[5]); w.w = pk2(s1[6], s1[7]); pb[2] = __builtin_bit_cast(bf16x8, w);
              w.x = pk2(s1[8], s1[9]); w.y = pk2(s1[10], s1[11]); w.z = pk2(s1[12], s1[13]); w.w = pk2(s1[14], s1[15]); pb[3] = __builtin_bit_cast(bf16x8, w); }
            if (!late) AT_PV(vcur);
        }
        if (t + 1 < NT) AT_STORE(buf ^ 1, vnext, par ^ 1);
        __syncthreads();
        vprev = vcur; vcur = vnext; vnext = (vnext == 2) ? 0 : vnext + 1;
    }
    }
    if (late && NT - 1 <= wlast) AT_PV(vprev);
    __syncthreads();
#undef AT_PV
#undef AT_LOAD
#undef AT_STORE
    const float ltot = FAST ? osum[0] : xhalf_sum(lrun), inv = 1.f / ltot;
    if (!DUAL) {
        if (qpos < q_hi) {
            bf16_t* op = Oh + (size_t)qpos * opitch + 4 * hi;
#pragma unroll
            for (int d = 0; d < DV / 32; ++d)
#pragma unroll
                for (int g4 = 0; g4 < 4; ++g4) { u32x2 w; w.x = pk2(o[d][4 * g4] * inv, o[d][4 * g4 + 1] * inv); w.y = pk2(o[d][4 * g4 + 2] * inv, o[d][4 * g4 + 3] * inv);
                    *(u32x2*)(op + 32 * d + 8 * g4) = w; }
        }
    } else {
        LAS f32x4* xo = (LAS f32x4*)lds + (wid & 3) * (DV / 8) * 64 + lane;
        if (wid >= 4) {
#pragma unroll
            for (int d = 0; d < DV / 32; ++d)
#pragma unroll
                for (int g4 = 0; g4 < 4; ++g4) xo[(4 * d + g4) * 64] = (f32x4){o[d][4 * g4] * inv, o[d][4 * g4 + 1] * inv, o[d][4 * g4 + 2] * inv, o[d][4 * g4 + 3] * inv};
        }
        __syncthreads();
        if (wid < 4) {
            float ss = 0.f;
#pragma unroll
            for (int d = 0; d < DV / 32; ++d)
#pragma unroll
                for (int g4 = 0; g4 < 4; ++g4) { const f32x4 o1 = xo[(4 * d + g4) * 64];
#pragma unroll
                    for (int j = 0; j < 4; ++j) { const float v = o[d][4 * g4 + j] * inv - lam * o1[j]; o[d][4 * g4 + j] = v; ss += v * v; } }
            ss = xhalf_sum(ss);
            const float rr = rsqrtf(ss * (1.f / DV) + EPS) * oscale;
            if (qpos < q_hi) {
                bf16_t* op = Oh + (size_t)qpos * opitch + 4 * hi;
#pragma unroll
                for (int d = 0; d < DV / 32; ++d)
#pragma unroll
                    for (int g4 = 0; g4 < 4; ++g4) { const f32x4 gg = *(const f32x4*)(gsub + 32 * d + 8 * g4 + 4 * hi);
                        u32x2 w; w.x = pk2(o[d][4 * g4] * rr * gg.x, o[d][4 * g4 + 1] * rr * gg.y); w.y = pk2(o[d][4 * g4 + 2] * rr * gg.z, o[d][4 * g4 + 3] * rr * gg.w);
                        *(u32x2*)(op + 32 * d + 8 * g4) = w; }
            }
        }
        __syncthreads();
    }
}

template <int MODE, int ABL = 0>
__device__ __forceinline__ void attn_phase(LAS unsigned char* lds, const bf16_t* Qb, const bf16_t* Kb, const bf16_t* Vb, bf16_t* Ob, int vcu, int G, int tid) {
    constexpr float L2E = 1.4426950408889634f;
    for (int flat = vcu; flat < 1024 + 128; flat += G) {
        int bh, ua, ub;
        if (flat < 1024) { const int f = flat & 255; bh = f >> 1; const int p = (f & 1) * 4 + (flat >> 8); ua = 16 - p; ub = 1 + p; }
        else { bh = flat - 1024; ua = 0; ub = -1; }
        const int b = bh >> 4, h = bh & 15;
        const size_t row0 = (size_t)b * SL;
#pragma unroll 1
        for (int k = 0; k < 2; ++k) {
            const int u = k ? ub : ua; if (u < 0) break;
            const int q_lo = u ? 16 + 256 * (u - 1) : 0, q_hi = u ? q_lo + 256 : 16;
            attn_unit<96, 64, false, false, true>(lds, Qb + row0 * 1536 + h * 96, 1536, Kb + row0 * 1536 + h * 96, 1536, Vb + row0 * 1024 + h * 64, 1024, Ob + row0 * 1024 + h * 64, 1024,
                                     q_lo, q_hi, 0.10206207261596577f * L2E, 0.f, tid);
        }
    }
}
__device__ __forceinline__ void diff_attn_phase(LAS unsigned char* lds, const bf16_t* QKV, bf16_t* Y, const float* lq1, const float* lk1, const float* lq2, const float* lk2, const float* gsub,
                                                float lambda_init, int vcu, int G, int tid) {
    constexpr float L2E = 1.4426950408889634f;
    const int lane = tid & 63;
    const float lam = __expf(wave_sum(lq1[lane] * lk1[lane], lane)) - __expf(wave_sum(lq2[lane] * lk2[lane], lane)) + lambda_init;
    for (int flat = vcu; flat < 1024 + 64; flat += G) {
        int bh, ua, ub;
        if (flat < 1024) { const int f = flat & 255; bh = f >> 2; const int p = (f & 3) * 4 + (flat >> 8); ua = 32 - p; ub = 1 + p; }
        else { bh = flat - 1024; ua = 0; ub = -1; }
        const int b = bh >> 3, h = bh & 7;
        const size_t row0 = (size_t)b * SL;
#pragma unroll 1
        for (int k = 0; k < 2; ++k) {
            const int u = k ? ub : ua; if (u < 0) break;
            const int q_lo = u ? 16 + 128 * (u - 1) : 0, q_hi = u ? q_lo + 128 : 16;
            attn_unit<64, 128, true, true, true>(lds, QKV + row0 * 3072 + h * 128, 3072, QKV + row0 * 3072 + 1024 + h * 128, 3072, QKV + row0 * 3072 + 2048 + h * 128, 3072, Y + row0 * 1024 + h * 128, 1024,
                                           q_lo, q_hi, 0.125f * L2E, exp2f(-(float)(h + 1)) * L2E, tid, lam, gsub, 1.f - lambda_init);
        }
    }
}

__device__ __forceinline__ void init_rows(const float* x, const float* meta, float* out, float* hm, const float* g0, bf16_t* XN, int gw, int NGW, int lane) {
    constexpr int RB = 4;
    for (int m0 = gw; m0 < MROWS; m0 += NGW * RB) {
        f32x4 v[RB][4];
#pragma unroll
        for (int k = 0; k < RB; ++k) { const int m = m0 + k * NGW, mc = m < MROWS ? m : MROWS - 1; const int b = mc / SL, t = mc - b * SL;
            const float* src = t < NMETA ? meta + (size_t)t * DM : x + ((size_t)b * SEQ + (t - NMETA)) * DM;
#pragma unroll
            for (int j = 0; j < 4; ++j) v[k][j] = __builtin_nontemporal_load((const f32x4*)(src + 4 * lane + 256 * j)); }
#pragma unroll
        for (int k = 0; k < RB; ++k) { const int m = m0 + k * NGW; if (m < MROWS) { float* h = hrow(out, hm, m);
#pragma unroll
            for (int j = 0; j < 4; ++j) __builtin_nontemporal_store(v[k][j], (f32x4*)(h + 4 * lane + 256 * j));
            rms_store_bf16(v[k], g0, XN + (size_t)m * DM, lane); } }
    }
}
__device__ __forceinline__ void nr_rows(const bf16_t* MO, float* out, float* hm, const float* ga, const float* gb, bf16_t* XN, int gw, int NGW, int lane) {
    constexpr int RB = 4;
    for (int m0 = gw; m0 < MROWS; m0 += NGW * RB) {
        float* h[RB]; u32x2 w[RB][4]; f32x4 hv[RB][4];
#pragma unroll
        for (int k = 0; k < RB; ++k) { const int m = m0 + k * NGW; const int mc = m < MROWS ? m : MROWS - 1; h[k] = hrow(out, hm, mc);
#pragma unroll
            for (int j = 0; j < 4; ++j) { w[k][j] = __builtin_nontemporal_load((const u32x2*)(MO + (size_t)mc * DM + 4 * lane + 256 * j)); hv[k][j] = __builtin_nontemporal_load((const f32x4*)(h[k] + 4 * lane + 256 * j)); } }
        float s[RB];
#pragma unroll
        for (int k = 0; k < RB; ++k) { s[k] = 0.f;
#pragma unroll
            for (int j = 0; j < 4; ++j) { const float a0 = bflo(w[k][j].x), a1 = bfhi(w[k][j].x), a2 = bflo(w[k][j].y), a3 = bfhi(w[k][j].y); s[k] += (a0 * a0 + a1 * a1) + (a2 * a2 + a3 * a3); } }
#pragma unroll
        for (int o = 1; o < 64; o <<= 1) {
#pragma unroll
            for (int k = 0; k < RB; ++k) s[k] += lane_xor(s[k], lane, o); }
        float s2[RB];
#pragma unroll
        for (int k = 0; k < RB; ++k) { const float r = rsqrtf(s[k] * (1.f / DM) + EPS); s2[k] = 0.f;
#pragma unroll
            for (int j = 0; j < 4; ++j) { const f32x4 gg = *(const f32x4*)(ga + 4 * lane + 256 * j);
                const f32x4 y = (f32x4){bflo(w[k][j].x), bfhi(w[k][j].x), bflo(w[k][j].y), bfhi(w[k][j].y)};
                hv[k][j] = hv[k][j] + y * r * gg;
                s2[k] += (hv[k][j].x * hv[k][j].x + hv[k][j].y * hv[k][j].y) + (hv[k][j].z * hv[k][j].z + hv[k][j].w * hv[k][j].w); } }
#pragma unroll
        for (int k = 0; k < RB; ++k) { if (m0 + k * NGW < MROWS) {
#pragma unroll
            for (int j = 0; j < 4; ++j) __builtin_nontemporal_store(hv[k][j], (f32x4*)(h[k] + 4 * lane + 256 * j)); } }
        if (gb) {
#pragma unroll
            for (int o = 1; o < 64; o <<= 1) {
#pragma unroll
                for (int k = 0; k < RB; ++k) s2[k] += lane_xor(s2[k], lane, o); }
#pragma unroll
            for (int k = 0; k < RB; ++k) { const int m = m0 + k * NGW; if (m < MROWS) { const float r2 = rsqrtf(s2[k] * (1.f / DM) + EPS);
#pragma unroll
                for (int j = 0; j < 4; ++j) { const f32x4 gg = *(const f32x4*)(gb + 4 * lane + 256 * j);
                    u32x2 ov; ov.x = pk2(hv[k][j].x * r2 * gg.x, hv[k][j].y * r2 * gg.y); ov.y = pk2(hv[k][j].z * r2 * gg.z, hv[k][j].w * r2 * gg.w);
                    *(u32x2*)(XN + (size_t)m * DM + 4 * lane + 256 * j) = ov; } } }
        }
    }
}
__device__ __forceinline__ void mla_norm_rows(const bf16_t* C, const float* gq, const float* gkv, const float* rope, bf16_t* NQ, bf16_t* NKV, bf16_t* Kb, int gw, int NGW, int lane) {
    for (int m = gw; m < MROWS; m += NGW) {
        const bf16_t* c = C + (size_t)m * 512;
        const int t = m % SL;
        { const u32x2 w = *(const u32x2*)(c + 4 * lane); const float a0 = bflo(w.x), a1 = bfhi(w.x), a2 = bflo(w.y), a3 = bfhi(w.y);
          const unsigned w2 = *(const unsigned*)(c + 256 + 2 * lane); const float b0 = bflo(w2), b1 = bfhi(w2);
          float sq = a0 * a0 + a1 * a1 + a2 * a2 + a3 * a3, skv = b0 * b0 + b1 * b1;
#pragma unroll
          for (int o = 1; o < 64; o <<= 1) { const float t1 = lane_xor(sq, lane, o), t2 = lane_xor(skv, lane, o); sq += t1; skv += t2; }
          const float r = rsqrtf(sq * (1.f / 256.f) + EPS), r2 = rsqrtf(skv * (1.f / 128.f) + EPS);
          const f32x4 gg = *(const f32x4*)(gq + 4 * lane);
          u32x2 o; o.x = pk2(a0 * r * gg.x, a1 * r * gg.y); o.y = pk2(a2 * r * gg.z, a3 * r * gg.w); *(u32x2*)(NQ + (size_t)m * 256 + 4 * lane) = o;
          *(unsigned*)(NKV + (size_t)m * 256 + 2 * lane) = pk2(b0 * r2 * gkv[2 * lane], b1 * r2 * gkv[2 * lane + 1]);
          *(unsigned*)(NKV + (size_t)m * 256 + 128 + 2 * lane) = 0u; }
        { const int e = lane & 31, i = e & 15;
          const float xs = bf2f(c[384 + e]), xo = bf2f(c[384 + (e ^ 16)]);
          const float cs = rope[t * 32 + i], sn = rope[t * 32 + 16 + i];
          const float v = (e < 16) ? (xs * cs - xo * sn) : (xs * cs + xo * sn);
          const unsigned short vb = (unsigned short)pg8::f2bf(v);
          bf16_t* kr = Kb + (size_t)m * 1536 + 64 + e;
#pragma unroll
          for (int k = 0; k < 8; ++k) kr[((lane >> 5) + 2 * k) * 96] = vb; }
    }
}
__device__ __forceinline__ void sc_rows(const bf16_t* T, const float* cw, bf16_t* Y, int gw, int NGW, int lane) {
    for (int m = gw; m < MROWS; m += NGW) {
        const int t = m % SL;
#pragma unroll
        for (int half = 0; half < 2; ++half) {
            const int col = 8 * lane + 512 * half;
            const bf16_t* p = T + (size_t)m * 3072 + col;
            const u32x4 gb = *(const u32x4*)p;
            u32x4 gc[3], uu[3];
#pragma unroll
            for (int k = 0; k < 3; ++k) { const bool ok = t >= k; const bf16_t* q = p - (ok ? (size_t)k * 3072 : 0);
                gc[k] = *(const u32x4*)(q + 1024); uu[k] = *(const u32x4*)(q + 2048); if (!ok) { gc[k] = (u32x4){0u, 0u, 0u, 0u}; } }
            float w[3][8];
#pragma unroll
            for (int k = 0; k < 3; ++k) { const f32x4 a = *(const f32x4*)(cw + k * DM + col), b2 = *(const f32x4*)(cw + k * DM + col + 4);
                w[k][0] = a.x; w[k][1] = a.y; w[k][2] = a.z; w[k][3] = a.w; w[k][4] = b2.x; w[k][5] = b2.y; w[k][6] = b2.z; w[k][7] = b2.w; }
            unsigned ow[4];
#pragma unroll
            for (int e2 = 0; e2 < 4; ++e2) {
                float r2[2];
#pragma unroll
                for (int q = 0; q < 2; ++q) { const int e = 2 * e2 + q; float acc = 0.f;
#pragma unroll
                    for (int k = 0; k < 3; ++k) { const float g = q ? bfhi(gc[k][e2]) : bflo(gc[k][e2]), u = q ? bfhi(uu[k][e2]) : bflo(uu[k][e2]); acc += w[2 - k][e] * (g * u); }
                    r2[q] = (q ? bfhi(gb[e2]) : bflo(gb[e2])) * acc; }
                ow[e2] = pk2(r2[0], r2[1]);
            }
            *(u32x4*)(Y + (size_t)m * DM + col) = (u32x4){ow[0], ow[1], ow[2], ow[3]};
        }
    }
}
__device__ __forceinline__ void diff_combine_rows(const bf16_t* O01, const float* lq1, const float* lk1, const float* lq2, const float* lk2, const float* gsub, float lambda_init, bf16_t* Y,
                                                  int gw, int NGW, int lane) {
    const float lam = __expf(wave_sum(lq1[lane] * lk1[lane], lane)) - __expf(wave_sum(lq2[lane] * lk2[lane], lane)) + lambda_init;
    const int head = lane >> 3, sub = lane & 7;
    float g[16];
#pragma unroll
    for (int i = 0; i < 16; ++i) g[i] = gsub[16 * sub + i] * (1.f - lambda_init);
    for (int m = gw; m < MROWS; m += NGW) {
        const bf16_t* p0 = O01 + (size_t)m * 2048 + (2 * head) * 128 + 16 * sub;
        const u32x4 a0 = __builtin_nontemporal_load((const u32x4*)p0), a1 = __builtin_nontemporal_load((const u32x4*)(p0 + 8)), b0 = __builtin_nontemporal_load((const u32x4*)(p0 + 128)), b1 = __builtin_nontemporal_load((const u32x4*)(p0 + 136));
        float d[16]; float s = 0.f;
#pragma unroll
        for (int i = 0; i < 4; ++i) {
            d[2 * i] = bflo(a0[i]) - lam * bflo(b0[i]); d[2 * i + 1] = bfhi(a0[i]) - lam * bfhi(b0[i]);
            d[8 + 2 * i] = bflo(a1[i]) - lam * bflo(b1[i]); d[8 + 2 * i + 1] = bfhi(a1[i]) - lam * bfhi(b1[i]); }
#pragma unroll
        for (int i = 0; i < 16; ++i) s += d[i] * d[i];
        s += lane_xor(s, lane, 1); s += lane_xor(s, lane, 2); s += lane_xor(s, lane, 4);
        const float r = rsqrtf(s * (1.f / 128.f) + EPS);
        u32x4 o0, o1;
#pragma unroll
        for (int i = 0; i < 4; ++i) { o0[i] = pk2(d[2 * i] * r * g[2 * i], d[2 * i + 1] * r * g[2 * i + 1]); o1[i] = pk2(d[8 + 2 * i] * r * g[8 + 2 * i], d[9 + 2 * i] * r * g[9 + 2 * i]); }
        bf16_t* q = Y + (size_t)m * DM + head * 128 + 16 * sub;
        *(u32x4*)q = o0; *(u32x4*)(q + 8) = o1;
    }
}

__device__ __forceinline__ void p0_prologue(LAS unsigned char* lds, bf16_t* Wb, float* rope, float* out, float* hm, bf16_t* XN, int gw, int NGW, int lane, int wave, int bx, int tid, int G) {
    const float* norms = INP(2);
    LAS float* scr = (LAS float*)(lds + wave * 16384);
    int cbase = 0;
        for (int j = 0; j < 2; ++j) {
            cvt_weight(INP(3) + (size_t)j * 1024 * 416, 1024, 416, Wb + W_MLA_IN + j * SZ_MLA_IN, 1024, 512, 0, scr, gw, NGW, lane, cbase);
            cvt_weight(INP(6) + (size_t)j * 256 * 1536, 256, 1536, Wb + W_MLA_UQ + j * SZ_MLA_UQ, 256, 1536, 0, scr, gw, NGW, lane, cbase);
            cvt_weight(INP(7) + (size_t)j * 128 * 2048, 128, 2048, Wb + W_MLA_UKV + j * SZ_MLA_UKV, 256, 2048, 0, scr, gw, NGW, lane, cbase);
            cvt_weight(INP(8) + (size_t)j * 1024 * 1024, 1024, 1024, Wb + W_MLA_O + j * SZ_SQ, 1024, 1024, 0, scr, gw, NGW, lane, cbase);
        }
        cvt_weight(INP(9), 1024, 3072, Wb + W_SC_IN, 1024, 3072, 0, scr, gw, NGW, lane, cbase);
        cvt_weight(INP(11), 1024, 1024, Wb + W_SC_OUT, 1024, 1024, 0, scr, gw, NGW, lane, cbase);
        cvt_weight(INP(12), 1024, 3072, Wb + W_DF_IN, 1024, 3072, 0, scr, gw, NGW, lane, cbase);
        cvt_weight(INP(18), 1024, 1024, Wb + W_DF_O, 1024, 1024, 0, scr, gw, NGW, lane, cbase);
        for (int i = 0; i < DEPTH; ++i) {
            cvt_weight(INP(19) + (size_t)i * 1024 * 5632, 1024, 5632, Wb + W_UP + i * SZ_UP, 1024, 5632, 1, scr, gw, NGW, lane, cbase);
            cvt_weight(INP(21) + (size_t)i * 2816 * 1024, 2816, 1024, Wb + W_DN + i * SZ_DN, 2816, 1024, 0, scr, gw, NGW, lane, cbase);
        }
        for (int idx = bx * NT_BLK + tid; idx < SL * 16; idx += G * NT_BLK) {
            const int pos = idx >> 4, i = idx & 15;
            const float invf = exp2f(-(float)(2 * i) * (13.287712379549449f / 32.f));
            const float ang = (float)pos * invf;
            double rev = (double)ang * 0.15915494309189535; rev -= floor(rev);
            const float rf = (float)rev;
            rope[pos * 32 + i] = __builtin_amdgcn_cosf(rf); rope[pos * 32 + 16 + i] = __builtin_amdgcn_sinf(rf);
        }
        init_rows(INP(0), INP(1), out, hm, norms, XN, gw, NGW, lane);
}

#define XB_TMO      128
#define XB_XCNT(j)  (256  + 64 * (j))
#define XB_XSUB(j)  (1280 + 64 * (j))
#define XB_XGEN(j)  (2304 + 64 * (j))
#define XB_TOP      3328
#define XB_TOPGEN   3392
#define XCD_BAR_WORDS 3456
#define XB_SPIN_CAP (1u << 18)
__device__ __forceinline__ unsigned xb_ld(unsigned* p)              { return __hip_atomic_load(p, __ATOMIC_RELAXED, __HIP_MEMORY_SCOPE_AGENT); }
__device__ __forceinline__ unsigned xb_add(unsigned* p, unsigned v) { return __hip_atomic_fetch_add(p, v, __ATOMIC_RELAXED, __HIP_MEMORY_SCOPE_AGENT); }
__device__ __forceinline__ unsigned xb_xcc_id() { return (unsigned)__builtin_amdgcn_s_getreg((3 << 11) | 20) & 0xFu; }
#define XB_SPIN(cond, bar) do { unsigned _sp = 0; while (cond) { __builtin_amdgcn_s_sleep(1); \
    if ((++_sp & 255u) == 0u) { if (xb_ld(&(bar)[XB_TMO])) break; if (_sp > XB_SPIN_CAP) { atomicAdd(&(bar)[XB_TMO], 1u); break; } } } } while (0)
struct XcdBarrier { unsigned* bar; unsigned x; volatile LAS unsigned* st; };
__device__ __forceinline__ XcdBarrier xcd_barrier_post(unsigned* bar, volatile LAS unsigned* st, int tid) {
    XcdBarrier b; b.bar = bar; b.x = xb_xcc_id(); b.st = st;
    if (tid == 0) (void)xb_add(&bar[XB_XCNT(b.x)], 1u);
    return b;
}
__device__ __forceinline__ void xcd_barrier_complete(unsigned* bar, unsigned x, unsigned& nloc, unsigned& nx) {
    const unsigned G = gridDim.x * gridDim.y * gridDim.z;
    unsigned sum, cnt, mine, sp = 0u;
    for (;;) {
        sum = 0u; cnt = 0u; mine = 0u;
#pragma unroll
        for (unsigned j = 0; j < 16; ++j) { const unsigned c = xb_ld(&bar[XB_XCNT(j)]); sum += c; cnt += (c > 0u) ? 1u : 0u; mine = (j == x) ? c : mine; }
        if (sum == G) break;
        __builtin_amdgcn_s_sleep(1);
        if ((++sp & 255u) == 0u) { if (xb_ld(&bar[XB_TMO])) break; if (sp > XB_SPIN_CAP) { atomicAdd(&bar[XB_TMO], 1u); break; } }
    }
    nloc = mine > 0u ? mine : 1u; nx = cnt > 0u ? cnt : 1u;
}
__device__ __forceinline__ void xcd_barrier(const XcdBarrier& b, int tid) {
    asm volatile("s_waitcnt vmcnt(0)" ::: "memory");
    __syncthreads();
    if (tid == 0) {
        unsigned* bar = b.bar; unsigned bx_ = b.x; asm volatile("" : "+s"(bx_));
        __builtin_amdgcn_s_waitcnt(0);
        unsigned nloc = b.st[0], nx = b.st[1];
        if (nloc == 0u) { xcd_barrier_complete(bar, bx_, nloc, nx); b.st[0] = nloc; b.st[1] = nx; }
        const unsigned old = xb_add(&bar[XB_XSUB(bx_)], 1u);
        const unsigned gen = old / nloc;
        if (old + 1u == (gen + 1u) * nloc) {
            __builtin_amdgcn_fence(__ATOMIC_RELEASE, "agent");
            asm volatile("s_waitcnt vmcnt(0)" ::: "memory");
            const unsigned og = xb_add(&bar[XB_TOP], 1u);
            const unsigned tg = og / nx;
            if (og + 1u == (tg + 1u) * nx) xb_add(&bar[XB_TOPGEN], 1u);
            else XB_SPIN(xb_ld(&bar[XB_TOPGEN]) == tg, bar);
            __builtin_amdgcn_fence(__ATOMIC_ACQUIRE, "agent");
            xb_add(&bar[XB_XGEN(bx_)], 1u);
            asm volatile("s_waitcnt vmcnt(0)" ::: "memory");
        } else {
            XB_SPIN(xb_ld(&bar[XB_XGEN(bx_)]) == gen, bar);
            __builtin_amdgcn_fence(__ATOMIC_ACQUIRE, "agent");
            asm volatile("s_waitcnt vmcnt(0)" ::: "memory");
        }
    }
    __syncthreads();
}
template <int K>
__device__ __forceinline__ void tail_gemm(LAS unsigned char* lds, const bf16_t* A, const bf16_t* Bt, int N, bf16_t* C, int ldc, int vcu, int G, int tid) {
    constexpr int ROW0 = 32768;
    const int lane = tid & 63, wave = __builtin_amdgcn_readfirstlane(tid >> 6), l16 = lane & 15, lq = lane >> 4;
    LAS float* red = (LAS float*)lds;
    const int ntn = N / 32, ntiles = 8 * ntn; constexpr int kw = K / 8, NS = kw / 32;
    for (int tile = vcu; tile < ntiles; tile += G) {
        const int tm = tile / ntn, tn = tile - tm * ntn;
        const bf16_t* ap = A + (size_t)(ROW0 + tm * 16 + l16) * K + wave * kw + 8 * lq;
        const bf16_t* bp = Bt + (size_t)(tn * 32 + l16) * K + wave * kw + 8 * lq;
        f32x4 c0 = (f32x4){0.f, 0.f, 0.f, 0.f}, c1 = c0;
        bf16x8 fa[NS], fb0[NS], fb1[NS];
#pragma unroll
        for (int s = 0; s < NS; ++s) { fa[s] = *(const bf16x8*)(ap + 32 * s); fb0[s] = *(const bf16x8*)(bp + 32 * s); fb1[s] = *(const bf16x8*)(bp + (size_t)16 * K + 32 * s); }
#pragma unroll
        for (int s = 0; s < NS; ++s) {
            c0 = __builtin_amdgcn_mfma_f32_16x16x32_bf16(fa[s], fb0[s], c0, 0, 0, 0);
            c1 = __builtin_amdgcn_mfma_f32_16x16x32_bf16(fa[s], fb1[s], c1, 0, 0, 0);
        }
#pragma unroll
        for (int e = 0; e < 4; ++e) { red[wave * 512 + (4 * lq + e) * 32 + l16] = c0[e]; red[wave * 512 + (4 * lq + e) * 32 + 16 + l16] = c1[e]; }
        __syncthreads();
        float s = 0.f;
#pragma unroll
        for (int w = 0; w < 8; ++w) s += red[w * 512 + tid];
        C[(size_t)(ROW0 + tm * 16 + (tid >> 5)) * ldc + tn * 32 + (tid & 31)] = (bf16_t)pg8::f2bf(s);
        __syncthreads();
    }
}
__device__ __forceinline__ int lane_id_opaque() { int l; asm volatile("v_mbcnt_lo_u32_b32 %0, -1, 0\n\tv_mbcnt_hi_u32_b32 %0, -1, %0" : "=v"(l)); return l; }
constexpr int N_PHASES = 33;
#define RPT_1(...) __VA_ARGS__
#define RPT_2(...) __VA_ARGS__ __VA_ARGS__
#define RPT_CAT(a, b) a##b
#define RPT_X(n, ...) RPT_CAT(RPT_, n)(__VA_ARGS__)
#define RPT(n, ...) RPT_X(n, __VA_ARGS__)
#ifndef PROBE_ABL
#define PROBE_ABL -1
#endif
#ifndef REP_ROWS
#define REP_ROWS 1
#endif
#ifndef REP_ATTN
#define REP_ATTN 1
#endif
#ifndef REP_UP
#define REP_UP 1
#endif
#ifndef REP_DN
#define REP_DN 1
#endif
#ifndef REP_MIX
#define REP_MIX 1
#endif
__global__ void __launch_bounds__(NT_BLK, 2) trunk_fwd(Args args) {
    extern __shared__ __attribute__((aligned(16))) unsigned char lds_raw[];
    LAS unsigned char* lds = (LAS unsigned char*)lds_raw;
    unsigned long long wsi = (unsigned long long)args.ws, outi = (unsigned long long)args.out;
#if MK_MULTI
    const int lo = args.ph_lo, hi = args.ph_hi;
#else
    constexpr int lo = 0, hi = N_PHASES;
#endif
    int ph = 0;
    const int wave0 = __builtin_amdgcn_readfirstlane((int)threadIdx.x >> 6);
#define MY_TID() (wave0 * 64 + lane_id_opaque())
#if !MK_MULTI
    volatile LAS unsigned* bst = (volatile LAS unsigned*)(lds + 131072);
    { const int t0 = MY_TID(); if (t0 < 4) bst[t0] = 0u; __syncthreads(); }
    const XcdBarrier xbar = xcd_barrier_post((unsigned*)args.ws, bst, MY_TID());
#endif
#define PH_BEGIN if (lo <= ph && ph < hi) { \
    int tid = MY_TID(), bx = blockIdx.x, G = gridDim.x; asm volatile("" : "+v"(tid), "+s"(bx), "+s"(G), "+s"(wsi), "+s"(outi)); unsigned char* ws = (unsigned char*)(GASP unsigned char*)wsi; float* out = (float*)(GASP float*)outi; \
    const int lane = tid & 63, wave = __builtin_amdgcn_readfirstlane(tid >> 6); \
    const int vcu = (G % 8 == 0) ? (bx % 8) * (G / 8) + bx / 8 : bx; const int gw = vcu * NW + wave, NGW = G * NW; \
    float* hm = (float*)(ws + WS_HM); float* rope = (float*)(ws + WS_ROPE); bf16_t* Wb = (bf16_t*)(ws + WS_W); bf16_t* XN = (bf16_t*)(ws + WS_XN); bf16_t* MO = (bf16_t*)(ws + WS_MO); unsigned char* R = ws + WS_R; \
    const float* norms = INP(2); (void)lane; (void)vcu; (void)gw; (void)NGW; (void)hm; (void)rope; (void)Wb; (void)XN; (void)MO; (void)R; (void)norms; (void)tid;
#if MK_MULTI
#define PH_END } ++ph;
#else
#define PH_END if (ph + 1 < hi) { if (ph == 0) cg::this_grid().sync(); else xcd_barrier(xbar, tid); } } ++ph;
#endif
#define GEMM(EPI, AOVF, Aptr, Btptr, KK, nM_, nN_, Eobj) do { pg8::Gemm g_{(const bf16_t*)(Aptr), (const bf16_t*)(Btptr), (KK)}; pg8::StaticOrder S_; S_.init((nM_), (nN_), G, bx); \
        pg8::gemm_phase<EPI, pg8::StaticOrder, AOVF>(lds, g_, S_, Eobj, tid); } while (0)

#define GEMM_T(Aptr, Btptr, KK, nN_, Cptr, ldc_) do { pg8::EpiBf16 E_{(bf16_t*)(Cptr), (ldc_)}; GEMM(pg8::EpiBf16, false, Aptr, Btptr, KK, 128, nN_, E_); \
        tail_gemm<KK>(lds, (const bf16_t*)(Aptr), (const bf16_t*)(Btptr), (nN_) * 256, (bf16_t*)(Cptr), (ldc_), vcu, G, tid); } while (0)
    PH_BEGIN RPT(REP_ROWS, p0_prologue(lds, Wb, rope, out, hm, XN, gw, NGW, lane, wave, bx, tid, G);) PH_END

    for (int layer = 0; layer < DEPTH; ++layer) {
        const int kind = layer % 3, j = layer / 3;
#define nrm (norms + (size_t)layer * 4 * DM)
        if (kind == 0) {
            PH_BEGIN RPT(REP_MIX, { GEMM_T(XN, Wb + W_MLA_IN + j * SZ_MLA_IN, 1024, 2, (bf16_t*)(R + R_C), 512); }) PH_END
            PH_BEGIN RPT(REP_ROWS, mla_norm_rows((const bf16_t*)(R + R_C), INP(4) + j * 256, INP(5) + j * 128, rope, (bf16_t*)(R + R_NQ), (bf16_t*)(R + R_NKV), (bf16_t*)(R + R_K), gw, NGW, lane);) PH_END
            PH_BEGIN RPT(REP_MIX, { pg8::EpiMlaQ E{(bf16_t*)(R + R_Q), rope}; GEMM(pg8::EpiMlaQ, false, R + R_NQ, Wb + W_MLA_UQ + j * SZ_MLA_UQ, 256, NM, 6, E); } { pg8::EpiMlaKV E{(bf16_t*)(R + R_K), MO}; GEMM(pg8::EpiMlaKV, false, R + R_NKV, Wb + W_MLA_UKV + j * SZ_MLA_UKV, 256, NM, 8, E); }) PH_END
            PH_BEGIN attn_phase<0>(lds, (const bf16_t*)(R + R_Q), (const bf16_t*)(R + R_K), MO, XN, vcu, G, tid); PH_END
            PH_BEGIN RPT(REP_MIX, { GEMM_T(XN, Wb + W_MLA_O + j * SZ_SQ, 1024, 4, MO, 1024); }) PH_END
        } else if (kind == 1) {
            PH_BEGIN RPT(REP_MIX, { GEMM_T(XN, Wb + W_SC_IN, 1024, 12, (bf16_t*)R, 3072); }) PH_END
            PH_BEGIN RPT(REP_ROWS, sc_rows((const bf16_t*)R, INP(10), XN, gw, NGW, lane);) PH_END
            PH_BEGIN RPT(REP_MIX, { GEMM_T(XN, Wb + W_SC_OUT, 1024, 4, MO, 1024); }) PH_END
        } else {
            const float lambda_init = 0.8f - 0.6f * __expf(-0.3f * (float)layer);
            PH_BEGIN RPT(REP_MIX, { GEMM_T(XN, Wb + W_DF_IN, 1024, 12, (bf16_t*)R, 3072); }) PH_END
            PH_BEGIN diff_attn_phase(lds, (const bf16_t*)R, XN, INP(13), INP(14), INP(15), INP(16), INP(17), lambda_init, vcu, G, tid); PH_END
            PH_BEGIN RPT(REP_MIX, { GEMM_T(XN, Wb + W_DF_O, 1024, 4, MO, 1024); }) PH_END
        }
        PH_BEGIN nr_rows(MO, out, hm, nrm + DM, nrm + 2 * DM, XN, gw, NGW, lane); PH_END
        PH_BEGIN RPT(REP_UP, { pg8::EpiFfnUp E{(bf16_t*)R, INP(20) + (size_t)layer * 3 * 5632, MROWS}; GEMM(pg8::EpiFfnUp, true, XN - 2 * DM, Wb + W_UP + layer * SZ_UP, 1024, NM_UP, 22, E); }) PH_END
        PH_BEGIN RPT(REP_DN, { GEMM_T(R, Wb + W_DN + layer * SZ_DN, 2816, 4, MO, 1024); }) PH_END
        PH_BEGIN nr_rows(MO, out, hm, nrm + 3 * DM, (layer + 1 < DEPTH) ? norms + (size_t)(layer + 1) * 4 * DM : nullptr, XN, gw, NGW, lane); PH_END
    }
#undef nrm
#undef PH_BEGIN
#undef PH_END
#undef GEMM
#undef GEMM_T
}

extern "C" void kernel_launch(void* const* d_in, const int* in_sizes, int n_in, void* d_out, int out_size, void* d_ws, size_t ws_size, hipStream_t stream) {
    static int grid = 0;
    if (grid == 0) {
        if (n_in != 22 || out_size != NB * SEQ * DM || ws_size < WS_END) { fprintf(stderr, "kernel_launch: unexpected shapes (n_in %d, out %d, ws %zu < %zu); nothing launched\n", n_in, out_size, ws_size, (size_t)WS_END); grid = -1; return; }
        int dev = 0, cus = 0, per_cu = 0;
        if (hipGetDevice(&dev) != hipSuccess || hipDeviceGetAttribute(&cus, hipDeviceAttributeMultiprocessorCount, dev) != hipSuccess) { grid = -1; return; }
        if (hipFuncSetAttribute((const void*)trunk_fwd, hipFuncAttributeMaxDynamicSharedMemorySize, LDS_BYTES) != hipSuccess) { fprintf(stderr, "kernel_launch: hipFuncSetAttribute failed\n"); grid = -1; return; }
        if (hipOccupancyMaxActiveBlocksPerMultiprocessor(&per_cu, (const void*)trunk_fwd, NT_BLK, LDS_BYTES) != hipSuccess || per_cu < 1) { fprintf(stderr, "kernel_launch: occupancy query says %d\n", per_cu); per_cu = 1; }
        (void)hipGetLastError();
        grid = cus;
    }
    if (grid < 0) return;
    Args a{};
    for (int i = 0; i < 22; ++i) a.in[i] = (const float*)d_in[i];
    a.out = (float*)d_out; a.ws = (unsigned char*)d_ws;
#if MK_MULTI
    for (int p = 0; p < N_PHASES; ++p) { a.ph_lo = p; a.ph_hi = p + 1; hipLaunchKernelGGL(trunk_fwd, dim3(grid), dim3(NT_BLK), LDS_BYTES, stream, a); }
#else
    a.ph_lo = 0; a.ph_hi = N_PHASES;
    if (hipMemsetAsync(d_ws, 0, 16384, stream) != hipSuccess) { fprintf(stderr, "kernel_launch: memset of the barrier words failed\n"); return; }
    void* kargs[] = {&a};
    hipError_t e = hipLaunchCooperativeKernel((const void*)trunk_fwd, dim3(grid), dim3(NT_BLK), kargs, LDS_BYTES, stream);
    if (e != hipSuccess) fprintf(stderr, "kernel_launch: cooperative launch failed: %s (grid %d)\n", hipGetErrorString(e), grid);
#endif
}
```

```cpp
#include <hip/hip_runtime.h>
#include <hip/hip_cooperative_groups.h>
#include <cstdio>
#include <cstdint>
namespace cg = cooperative_groups;

#ifndef MK_MULTI
#define MK_MULTI 0
#endif

namespace pg8 {
#define PG8_LAS __attribute__((address_space(3)))
typedef unsigned short bf16_t;
typedef short bf16x8 __attribute__((ext_vector_type(8)));
typedef float f32x4 __attribute__((ext_vector_type(4)));
typedef unsigned u32x4 __attribute__((ext_vector_type(4)));
typedef unsigned u32x2 __attribute__((ext_vector_type(2)));
constexpr int BM = 256, BK = 64, HALF = 128, HTB = HALF * BK * 2  , STAGE_BYTES = 8 * HTB, NXCD = 8, WGM = 8;

__host__ __device__ __forceinline__ int lds_byte(int r, int c) { const int st = (r >> 4) * 2 + (c >> 5), rr = r & 15, cc = c & 31, ob = rr * 64 + cc * 2; return st * 1024 + (ob ^ (((ob >> 9) & 1) << 5)); }
__host__ __device__ __forceinline__ void stage_rc(int b, int& R, int& C) { const int st = b / 1024, sb = b % 1024, swz = sb ^ (((sb >> 9) & 1) << 5); R = (st >> 1) * 16 + swz / 64; C = (st & 1) * 32 + (swz % 64) / 2; }
__host__ __device__ __forceinline__ int perm32(int rho) { const int n = rho >> 4, i = rho & 15; return 8 * (i >> 2) + 4 * n + (i & 3); }

struct Unit { int pm, pn; };
struct Gemm { const bf16_t* A; const bf16_t* Bt; int K; };

struct StaticOrder {
    int nM, nN, nwg, G, c;
    __host__ __device__ void init(int nM_, int nN_, int G_, int c_) { nM = nM_; nN = nN_; nwg = nM * nN; G = G_; c = c_; }
    __host__ __device__ bool next(int i, Unit& u) const {
        const long L = (long)i * G + c; if (L >= nwg) return false;
        int wgid = (int)L; { const int q = nwg / NXCD, r = nwg % NXCD, xcd = wgid % NXCD, off = wgid / NXCD; wgid = (xcd < r ? xcd * (q + 1) : r * (q + 1) + (xcd - r) * q) + off; }
        const int nig = WGM * nN, gid = wgid / nig, fm = gid * WGM, gsz = (nM - fm) < WGM ? (nM - fm) : WGM;
        u.pm = fm + ((wgid % nig) % gsz); u.pn = (wgid % nig) / gsz; return true;
    }
};

__device__ __forceinline__ unsigned cvt_pk_bf16(float lo, float hi) { unsigned r; asm volatile("v_cvt_pk_bf16_f32 %0, %1, %2" : "=v"(r) : "v"(lo), "v"(hi)); return r; }

struct EpiBf16 {
    static constexpr bool PERM = true;
    bf16_t* O; int ldc;
    __device__ __forceinline__ void operator()(const f32x4 (&acc)[2][2][4][2], const Unit& u, int wr, int wc, int fr, int fq) const {
        const int row0 = u.pm * BM + wr * 64 + fr; const int col0 = u.pn * BM + wc * 32 + 8 * fq;
#pragma unroll
        for (int ai = 0; ai < 2; ++ai)
#pragma unroll
            for (int m = 0; m < 4; ++m) { bf16_t* rowp = O + (size_t)(row0 + ai * HALF + m * 16) * ldc + col0;
#pragma unroll
                for (int bj = 0; bj < 2; ++bj) { const f32x4 v0 = acc[ai][bj][m][0], v1 = acc[ai][bj][m][1];
                    u32x4 w; w.x = cvt_pk_bf16(v0[0], v0[1]); w.y = cvt_pk_bf16(v0[2], v0[3]); w.z = cvt_pk_bf16(v1[0], v1[1]); w.w = cvt_pk_bf16(v1[2], v1[3]);
                    *(u32x4*)(rowp + bj * HALF) = w; } }
    }
};
template <class Epi, class Sched, bool AOV = false>
__device__ __forceinline__ void gemm_phase(PG8_LAS unsigned char* lds, const Gemm g, const Sched& S, const Epi& E, int tid_in) {
    int tid_ = tid_in; asm volatile("" : "+v"(tid_));
    const int tid = tid_, wid = __builtin_amdgcn_readfirstlane(tid >> 6), lane = tid & 63, wr = wid >> 2, wc = wid & 3, fr = lane & 15, fq = lane >> 4;
    const int K = g.K, nt = K / BK;
    unsigned voffA[2], voffB[2];
#pragma unroll
    for (int i = 0; i < 2; ++i) { int R, C; stage_rc(tid * 16 + i * 8192, R, C); const int Rb = Epi::PERM ? ((R & ~31) + perm32(R & 31)) : R;
        voffA[i] = (unsigned)((AOV ? (R - 2 * (R >> 6)) : R) * K + C) * 2u; voffB[i] = (unsigned)(Rb * K + C) * 2u; }
    const size_t kstep = (size_t)(BK * 2);
    const size_t hstepB = (size_t)HALF * K * 2, hstepA = (size_t)(AOV ? 124 : HALF) * K * 2;
    const size_t tstepA = 2 * hstepA, tstepB = 2 * hstepB;
    const unsigned ldsw = (unsigned)wid * 1024u;
    const int aoff = lds_byte(wr * 64 + fr, fq * 8), boff = lds_byte(wc * 32 + fr, fq * 8);
#define PG8_SA(b, h) (((b) * 2 + (h)) * HTB)
#define PG8_SB(b, h) ((4 + (b) * 2 + (h)) * HTB)
#define PG8_STAGE(bufoff, gbase, voff) do { _Pragma("unroll") for (int _i = 0; _i < 2; ++_i) \
        __builtin_amdgcn_global_load_lds((const unsigned*)((const char*)(gbase) + (voff)[_i]), (PG8_LAS unsigned*)(lds + (bufoff) + ldsw + _i * 8192), 16, 0, 0); } while (0)
#define PG8_LDA(dst, b, h) do { _Pragma("unroll") for (int m = 0; m < 4; ++m) _Pragma("unroll") for (int k = 0; k < 2; ++k) dst[m][k] = *(const PG8_LAS bf16x8*)(lds + PG8_SA(b, h) + aoff + m * 2048 + k * 1024); } while (0)
#define PG8_LDB(dst, b, h) do { _Pragma("unroll") for (int n = 0; n < 2; ++n) _Pragma("unroll") for (int k = 0; k < 2; ++k) dst[n][k] = *(const PG8_LAS bf16x8*)(lds + PG8_SB(b, h) + boff + n * 2048 + k * 1024); } while (0)
#define PG8_MMA(ai, bj, At, Bt) do { __builtin_amdgcn_s_setprio(1); _Pragma("unroll") for (int m = 0; m < 4; ++m) _Pragma("unroll") for (int n = 0; n < 2; ++n) _Pragma("unroll") for (int k = 0; k < 2; ++k) \
        acc[ai][bj][m][n] = __builtin_amdgcn_mfma_f32_16x16x32_bf16(Bt[n][k], At[m][k], acc[ai][bj][m][n], 0, 0, 0); __builtin_amdgcn_s_setprio(0); } while (0)
#define PG8_WAIT_V(n) asm volatile("s_waitcnt vmcnt(" #n ")" ::: "memory")
#define PG8_WAIT_L(n) asm volatile("s_waitcnt lgkmcnt(" #n ")" ::: "memory")
#define PG8_BAR __builtin_amdgcn_s_barrier()
#define PG8_SCHED __builtin_amdgcn_sched_barrier(0)
    Unit cur, nxt; int ui = 0;
    if (!S.next(0, cur)) return;
    f32x4 acc[2][2][4][2];
#pragma unroll
    for (int a = 0; a < 2; ++a)
#pragma unroll
        for (int b = 0; b < 2; ++b)
#pragma unroll
            for (int m = 0; m < 4; ++m)
#pragma unroll
                for (int n = 0; n < 2; ++n) acc[a][b][m][n] = (f32x4){0.f, 0.f, 0.f, 0.f};
    bf16x8 At[4][2], B0[2][2], B1[2][2];
    const char* cA = (const char*)g.A + (size_t)cur.pm * tstepA; const char* cB = (const char*)g.Bt + (size_t)cur.pn * tstepB;
    PG8_STAGE(PG8_SB(0, 0), cB, voffB); PG8_STAGE(PG8_SA(0, 0), cA, voffA); PG8_STAGE(PG8_SB(0, 1), cB + hstepB, voffB); PG8_STAGE(PG8_SA(0, 1), cA + hstepA, voffA);
    if (wr == 1) PG8_BAR;
    PG8_WAIT_V(4); PG8_BAR;
    PG8_STAGE(PG8_SB(1, 0), cB + kstep, voffB); PG8_STAGE(PG8_SA(1, 0), cA + kstep, voffA); PG8_STAGE(PG8_SB(1, 1), cB + hstepB + kstep, voffB);
    PG8_WAIT_V(6); PG8_BAR;
    for (;;) {
        const bool has_next = S.next(ui + 1, nxt);
        const char* nA = has_next ? (const char*)g.A + (size_t)nxt.pm * tstepA : cA; const char* nB = has_next ? (const char*)g.Bt + (size_t)nxt.pn * tstepB : cB;
        for (int t = 0; t < nt; t += 2) {
            const bool last = (t == nt - 2);
            const char* a1 = cA + (size_t)(t + 1) * kstep;
            const char* a2 = last ? nA : cA + (size_t)(t + 2) * kstep; const char* b2 = last ? nB : cB + (size_t)(t + 2) * kstep;
            const char* a3 = a2 + kstep; const char* b3 = b2 + kstep;
            PG8_LDB(B0, 0, 0); PG8_SCHED; PG8_LDA(At, 0, 0); PG8_STAGE(PG8_SA(1, 1), a1 + hstepA, voffA);
            PG8_WAIT_L(8); PG8_BAR; PG8_WAIT_L(0); PG8_MMA(0, 0, At, B0); PG8_BAR; PG8_SCHED;
            PG8_LDB(B1, 0, 1); PG8_STAGE(PG8_SB(0, 0), b2, voffB);
            PG8_BAR; PG8_WAIT_L(0); PG8_MMA(0, 1, At, B1); PG8_BAR;
            PG8_LDA(At, 0, 1); PG8_STAGE(PG8_SA(0, 0), a2, voffA);
            PG8_BAR; PG8_WAIT_L(0); PG8_MMA(1, 0, At, B0); PG8_BAR; PG8_SCHED;
            PG8_STAGE(PG8_SB(0, 1), b2 + hstepB, voffB);
            PG8_WAIT_V(6); PG8_BAR; PG8_MMA(1, 1, At, B1); PG8_BAR;
            PG8_LDB(B0, 1, 0); PG8_SCHED; PG8_LDA(At, 1, 0); PG8_STAGE(PG8_SA(0, 1), a2 + hstepA, voffA);
            PG8_WAIT_L(8); PG8_BAR; PG8_WAIT_L(0); PG8_MMA(0, 0, At, B0); PG8_BAR; PG8_SCHED;
            PG8_LDB(B1, 1, 1); PG8_STAGE(PG8_SB(1, 0), b3, voffB);
            PG8_BAR; PG8_WAIT_L(0); PG8_MMA(0, 1, At, B1); PG8_BAR;
            PG8_LDA(At, 1, 1); PG8_STAGE(PG8_SA(1, 0), a3, voffA);
            PG8_BAR; PG8_WAIT_L(0); PG8_MMA(1, 0, At, B0); PG8_BAR; PG8_SCHED;
            PG8_STAGE(PG8_SB(1, 1), b3 + hstepB, voffB);
            PG8_WAIT_V(6); PG8_BAR; PG8_MMA(1, 1, At, B1); PG8_BAR;
        }
        E(acc, cur, wr, wc, fr, fq);
        if (!has_next) break;
#pragma unroll
        for (int a = 0; a < 2; ++a)
#pragma unroll
            for (int b = 0; b < 2; ++b)
#pragma unroll
                for (int m = 0; m < 4; ++m)
#pragma unroll
                    for (int n = 0; n < 2; ++n) acc[a][b][m][n] = (f32x4){0.f, 0.f, 0.f, 0.f};
        cur = nxt; cA = nA; cB = nB; ++ui;
    }
    PG8_WAIT_V(0);
    if (wr == 0) PG8_BAR;
    PG8_BAR;
#undef PG8_SA
#undef PG8_SB
#undef PG8_STAGE
#undef PG8_LDA
#undef PG8_LDB
#undef PG8_MMA
#undef PG8_WAIT_V
#undef PG8_WAIT_L
#undef PG8_BAR
#undef PG8_SCHED
}
}


namespace pg8 {
constexpr int SEQ_L = 4112;
template <int CTRL> __device__ __forceinline__ float dppf(float v) { return __builtin_bit_cast(float, __builtin_amdgcn_update_dpp(0, __builtin_bit_cast(int, v), CTRL, 0xf, 0xf, true)); }
template <int CTRL> __device__ __forceinline__ float dppo(float old, float v) { return __builtin_bit_cast(float, __builtin_amdgcn_update_dpp(__builtin_bit_cast(int, old), __builtin_bit_cast(int, v), CTRL, 0xf, 0xf, false)); }
__device__ __forceinline__ unsigned f2bf(float f) { unsigned u = __builtin_bit_cast(unsigned, f); return (u + 0x7fffu + ((u >> 16) & 1u)) >> 16; }
typedef float f32x2_t __attribute__((ext_vector_type(2))); typedef __bf16 bf16x2_t __attribute__((ext_vector_type(2)));
__device__ __forceinline__ unsigned pk2(float lo, float hi) { f32x2_t v = {lo, hi}; bf16x2_t b = __builtin_convertvector(v, bf16x2_t); return __builtin_bit_cast(unsigned, b); }

constexpr float QK_SCALE_L2E = 0.10206207261596577f * 1.4426950408889634f;
struct EpiMlaQ {
    static constexpr bool PERM = false;
    bf16_t* Q; const float* rope;
    __device__ __forceinline__ void operator()(const f32x4 (&acc)[2][2][4][2], const Unit& u, int wr, int wc, int fr, int fq) const {
#pragma unroll
        for (int ai = 0; ai < 2; ++ai)
#pragma unroll
            for (int m = 0; m < 4; ++m) {
                const int row = u.pm * BM + ai * HALF + wr * 64 + m * 16 + fr;
                const int t = row % SEQ_L;
                const f32x4 cs = *(const f32x4*)(rope + t * 32 + 4 * fq), sn = *(const f32x4*)(rope + t * 32 + 16 + 4 * fq);
#pragma unroll
                for (int bj = 0; bj < 2; ++bj) {
                    const int c32 = u.pn * BM + bj * HALF + wc * 32;
                    f32x4 v0 = acc[ai][bj][m][0], v1 = acc[ai][bj][m][1];
                    if (((c32 >> 5) % 3) == 2) { const f32x4 x1 = v0, x2 = v1; v0 = x1 * cs - x2 * sn; v1 = x2 * cs + x1 * sn; }
                    v0 *= QK_SCALE_L2E; v1 *= QK_SCALE_L2E;
                    bf16_t* p = Q + (size_t)row * 1536 + c32 + 4 * fq;
                    u32x2 w0, w1; w0.x = pk2(v0[0], v0[1]); w0.y = pk2(v0[2], v0[3]); w1.x = pk2(v1[0], v1[1]); w1.y = pk2(v1[2], v1[3]);
                    *(u32x2*)p = w0; *(u32x2*)(p + 16) = w1;
                }
                asm volatile("" ::: "memory");
            }
    }
};
struct EpiMlaKV {
    static constexpr bool PERM = false;
    bf16_t* Kb; bf16_t* Vb;
    __device__ __forceinline__ void operator()(const f32x4 (&acc)[2][2][4][2], const Unit& u, int wr, int wc, int fr, int fq) const {
#pragma unroll
        for (int ai = 0; ai < 2; ++ai)
#pragma unroll
            for (int m = 0; m < 4; ++m) {
                const int row = u.pm * BM + ai * HALF + wr * 64 + m * 16 + fr;
#pragma unroll
                for (int bj = 0; bj < 2; ++bj) {
                    const int head = u.pn * 2 + bj;
                    bf16_t* p = (wc < 2) ? (Kb + (size_t)row * 1536 + head * 96 + wc * 32 + 4 * fq) : (Vb + (size_t)row * 1024 + head * 64 + (wc - 2) * 32 + 4 * fq);
                    const f32x4 v0 = acc[ai][bj][m][0], v1 = acc[ai][bj][m][1];
                    u32x2 w0, w1; w0.x = pk2(v0[0], v0[1]); w0.y = pk2(v0[2], v0[3]); w1.x = pk2(v1[0], v1[1]); w1.y = pk2(v1[2], v1[3]);
                    *(u32x2*)p = w0; *(u32x2*)(p + 16) = w1;
                }
            }
    }
};
struct EpiFfnUp {
    static constexpr bool PERM = false;
    bf16_t* ACT; const float* cw; int Mrows;
    __device__ __forceinline__ void operator()(const f32x4 (&acc)[2][2][4][2], const Unit& u, int wr, int wc, int fr, int fq) const {
#pragma unroll
        for (int n = 0; n < 2; ++n) {
            const int col = u.pn * 128 + wc * 32 + n * 16 + 4 * fq;
            const f32x4 g0 = *(const f32x4*)(cw + col), g1 = *(const f32x4*)(cw + 5632 + col), g2 = *(const f32x4*)(cw + 2 * 5632 + col);
            const f32x4 u0 = *(const f32x4*)(cw + 2816 + col), u1 = *(const f32x4*)(cw + 5632 + 2816 + col), u2 = *(const f32x4*)(cw + 2 * 5632 + 2816 + col);
#pragma unroll
            for (int ai = 0; ai < 2; ++ai)
#pragma unroll
                for (int m = 0; m < 4; ++m) {
                    const int grow = u.pm * 248 + ai * 124 + wr * 62 + m * 16 + fr - 2;
                    const int t = (grow + SEQ_L) % SEQ_L;
                    const bool ok = (m * 16 + fr >= 2) && grow < Mrows;
                    const bool edge = __any(t <= 1);
                    float r[4];
#pragma unroll
                    for (int j = 0; j < 4; ++j) {
                        const float gc = acc[ai][0][m][n][j], uc = acc[ai][1][m][n][j];
                        float go1 = 0.f, go2 = 0.f, uo1 = 0.f, uo2 = 0.f;
                        if (m > 0) { const float gq = acc[ai][0][m - 1][n][j], uq = acc[ai][1][m - 1][n][j];
                            go1 = dppf<0x10F>(gq); go2 = dppf<0x10E>(gq); uo1 = dppf<0x10F>(uq); uo2 = dppf<0x10E>(uq); }
                        float gp1 = dppo<0x111>(go1, gc), gp2 = dppo<0x112>(go2, gc), up1 = dppo<0x111>(uo1, uc), up2 = dppo<0x112>(uo2, uc);
                        if (edge) { if (t == 0) { gp1 = 0.f; up1 = 0.f; } if (t <= 1) { gp2 = 0.f; up2 = 0.f; } }
                        const float G = g2[j] * gc + g1[j] * gp1 + g0[j] * gp2;
                        const float U = u2[j] * uc + u1[j] * up1 + u0[j] * up2;
                        r[j] = G * U * __builtin_amdgcn_rcpf(1.f + __builtin_amdgcn_exp2f(-1.4426950408889634f * G));
                    }
                    if (ok) { u32x2 w; w.x = pk2(r[0], r[1]); w.y = pk2(r[2], r[3]); *(u32x2*)(ACT + (size_t)grow * 2816 + col) = w; }
                }
        }
    }
};
}

#define LAS __attribute__((address_space(3)))
typedef unsigned short bf16_t;
typedef short bf16x8 __attribute__((ext_vector_type(8)));
typedef short s16x4 __attribute__((ext_vector_type(4)));
typedef float f32x4 __attribute__((ext_vector_type(4)));
typedef float f32x16 __attribute__((ext_vector_type(16)));
typedef unsigned u32x4 __attribute__((ext_vector_type(4)));
typedef unsigned u32x2 __attribute__((ext_vector_type(2)));
using pg8::pk2;

constexpr int NW = 8, NT_BLK = NW * 64;
constexpr int DM = 1024, NB = 8, SEQ = 4096, NMETA = 16, SL = 4112, MROWS = NB * SL  , MP = 33024  , FF = 2816, DEPTH = 4;
constexpr float EPS = 1e-6f;
static_assert(SL == pg8::SEQ_L, "seq");
constexpr int NM = MP / 256;
constexpr int NM_UP = 133;

constexpr size_t MiB = 1u << 20;
constexpr size_t WS_ROPE = 1 * MiB;
constexpr size_t WS_HM = 2 * MiB;
constexpr size_t WS_W = 4 * MiB;
constexpr size_t WS_XN = 97 * MiB;
constexpr size_t ROWB = (size_t)MP * 2048;
constexpr size_t WS_MO = WS_XN + ROWB;
constexpr size_t WS_R = WS_MO + ROWB;
constexpr size_t WS_END = WS_R + 230 * MiB;
constexpr size_t W_MLA_IN = 0, SZ_MLA_IN = 512 * 1024;
constexpr size_t W_MLA_UQ = W_MLA_IN + 2 * SZ_MLA_IN, SZ_MLA_UQ = 1536 * 256;
constexpr size_t W_MLA_UKV = W_MLA_UQ + 2 * SZ_MLA_UQ, SZ_MLA_UKV = 2048 * 256;
constexpr size_t W_MLA_O = W_MLA_UKV + 2 * SZ_MLA_UKV, SZ_SQ = 1024 * 1024;
constexpr size_t W_SC_IN = W_MLA_O + 2 * SZ_SQ, SZ_3D = 3072 * 1024;
constexpr size_t W_SC_OUT = W_SC_IN + SZ_3D;
constexpr size_t W_DF_IN = W_SC_OUT + SZ_SQ;
constexpr size_t W_DF_O = W_DF_IN + SZ_3D;
constexpr size_t W_UP = W_DF_O + SZ_SQ, SZ_UP = 5632 * 1024;
constexpr size_t W_DN = W_UP + 4 * SZ_UP, SZ_DN = 1024 * 2816;
constexpr size_t W_TOTAL = W_DN + 4 * SZ_DN;
static_assert(WS_W + W_TOTAL * 2 + 8192 <= WS_XN, "weights fit");
constexpr size_t R_NQ = 0, R_NKV = 17 * MiB, R_Q = 34 * MiB, R_C = 34 * MiB, R_K = 131 * MiB;
static_assert(R_K + (size_t)MP * 1536 * 2 <= 230 * MiB && R_Q + (size_t)MP * 1536 * 2 <= R_K && (size_t)MP * 3072 * 2 <= 230 * MiB, "R map");

constexpr int LDS_BYTES = 131072 + 1024;

struct Args { const float* in[22]; float* out; unsigned char* ws; int ph_lo, ph_hi; };

#define GASP __attribute__((address_space(1)))
#define INP(i) ld_inp<(i)>()
template <int I> __device__ __forceinline__ const float* ld_inp() {
    unsigned long long v; asm volatile("s_load_dwordx2 %0, %1, %2\n\ts_waitcnt lgkmcnt(0)" : "=s"(v) : "s"(__builtin_amdgcn_kernarg_segment_ptr()), "i"(I * 8));
    return (const float*)(GASP const float*)v;
}
__device__ __forceinline__ float lane_xor(float v, int lane, int o) { return __builtin_bit_cast(float, __builtin_amdgcn_ds_bpermute((lane ^ o) << 2, __builtin_bit_cast(int, v))); }
__device__ __forceinline__ float wave_sum(float v, int lane) {
#pragma unroll
    for (int o = 1; o < 64; o <<= 1) v += lane_xor(v, lane, o);
    return v;
}
__device__ __forceinline__ float bf2f(unsigned short b) { return __builtin_bit_cast(float, (unsigned)b << 16); }
__device__ __forceinline__ float bflo(unsigned w) { return __builtin_bit_cast(float, w << 16); }
__device__ __forceinline__ float bfhi(unsigned w) { return __builtin_bit_cast(float, w & 0xffff0000u); }
__device__ __forceinline__ float* hrow(float* out, float* hm, int m) {
    const int b = m / SL, t = m - b * SL;
    return t < NMETA ? hm + (size_t)(b * NMETA + t) * DM : out + ((size_t)b * SEQ + (t - NMETA)) * DM;
}

__device__ __forceinline__ void cvt_weight(const float* W, int Ks, int Ns, bf16_t* WT, int Kd, int Nd, int mode, LAS float* scr, int gw, int NGW, int lane, int& base) {
    const int nblk = Nd / 32, nitems = (Kd / 64) * nblk;
    int first = (gw - base) % NGW; if (first < 0) first += NGW;
    base = (base + nitems) % NGW;
    for (int it = first; it < nitems; it += NGW) {
        const int kb = it / nblk, nb = it - kb * nblk, k0 = 64 * kb, p0 = 32 * nb;
        int lc = p0;
        if (mode == 1) { const int pn = p0 >> 8, j = p0 & 255; lc = (j < 128) ? 128 * pn + j : FF + 128 * pn + (j - 128); }
        const bool zero = (lc >= Ns) || (k0 >= Ks);
        { f32x4 v[8];
#pragma unroll
          for (int i = 0; i < 8; ++i) { const int kk = 8 * i + (lane >> 3); v[i] = zero ? (f32x4){0.f, 0.f, 0.f, 0.f} : __builtin_nontemporal_load((const f32x4*)(W + (size_t)(k0 + kk) * Ns + lc + 4 * (lane & 7))); }
#pragma unroll
          for (int i = 0; i < 8; ++i) { const int kk = 8 * i + (lane >> 3); LAS float* d = scr + kk * 33 + 4 * (lane & 7); d[0] = v[i].x; d[1] = v[i].y; d[2] = v[i].z; d[3] = v[i].w; } }
        asm volatile("s_waitcnt lgkmcnt(0)" ::: "memory");
        const int c = lane & 7;
#pragma unroll
        for (int j = 0; j < 4; ++j) { const int n = (lane >> 3) + 8 * j; const LAS float* s = scr + (8 * c) * 33 + n;
            u32x4 o; o.x = pk2(s[0 * 33], s[1 * 33]); o.y = pk2(s[2 * 33], s[3 * 33]); o.z = pk2(s[4 * 33], s[5 * 33]); o.w = pk2(s[6 * 33], s[7 * 33]);
            *(u32x4*)(WT + (size_t)(p0 + n) * Kd + k0 + 8 * c) = o; }
        asm volatile("s_waitcnt lgkmcnt(0)" ::: "memory");
    }
}

__device__ __forceinline__ void rms_store_bf16(const f32x4 (&v)[4], const float* g, bf16_t* orow, int lane) {
    float s = 0.f;
#pragma unroll
    for (int j = 0; j < 4; ++j) s += (v[j].x * v[j].x + v[j].y * v[j].y) + (v[j].z * v[j].z + v[j].w * v[j].w);
    const float r = rsqrtf(wave_sum(s, lane) * (1.f / DM) + EPS);
#pragma unroll
    for (int j = 0; j < 4; ++j) { const f32x4 gg = *(const f32x4*)(g + 4 * lane + 256 * j);
        u32x2 w; w.x = pk2(v[j].x * r * gg.x, v[j].y * r * gg.y); w.y = pk2(v[j].z * r * gg.z, v[j].w * r * gg.w);
        *(u32x2*)(orow + 4 * lane + 256 * j) = w; }
}

__device__ __forceinline__ s16x4 vtr(const LAS unsigned char* p) { typedef short v4i16_t __attribute__((ext_vector_type(4)));
    return __builtin_bit_cast(s16x4, __builtin_amdgcn_ds_read_tr16_b64_v4i16((LAS v4i16_t*)p)); }
__device__ __forceinline__ int crow(int r, int hi) { return (r & 3) + 8 * (r >> 2) + 4 * hi; }
__device__ __forceinline__ float xhalf_max(float m) { auto rr = __builtin_amdgcn_permlane32_swap(__float_as_uint(m), __float_as_uint(m), false, false); return fmaxf(__uint_as_float(rr[0]), __uint_as_float(rr[1])); }
__device__ __forceinline__ float xhalf_sum(float m) { auto rr = __builtin_amdgcn_permlane32_swap(__float_as_uint(m), __float_as_uint(m), false, false); return __uint_as_float(rr[0]) + __uint_as_float(rr[1]); }

template <int DQK, int DV, bool ALIBI, bool DUAL = false, bool FAST = false>
__device__ __forceinline__ void attn_unit(LAS unsigned char* lds, const bf16_t* Qh, int qpitch, const bf16_t* Kh, int kpitch, const bf16_t* Vh, int vpitch, bf16_t* Oh, int opitch,
                                          int q_lo, int q_hi, float c1, float c2, int tid_in, float lam = 0.f, const float* gsub = nullptr, float oscale = 1.f) {
    constexpr int KW = DUAL ? 2 * DQK : DQK;
    constexpr int KP = KW * 2 + 16, VP = DV * 2 + 64, KBYTES = 64 * KP, VBYTES = 64 * VP, BUF = KBYTES + VBYTES;
    constexpr int KCH = KW / 8, VCH = DV / 8, NKC = 64 * KCH, NVC = 64 * VCH, KPT = (NKC + NT_BLK - 1) / NT_BLK, VPT = (NVC + NT_BLK - 1) / NT_BLK;
    static_assert(2 * KBYTES + 3 * VBYTES <= 131072, "attention LDS");
    int tid_ = tid_in; asm volatile("" : "+v"(tid_));
    const int tid = tid_, lane = tid & 63, r32 = lane & 31, hi = lane >> 5; const int wid = __builtin_amdgcn_readfirstlane(tid >> 6);
    const int mapi = DUAL ? (wid >> 2) : 0;
    const int wq0 = q_lo + 32 * (DUAL ? (wid & 3) : wid), qpos = wq0 + r32;
    const int NT = (q_hi + 63) >> 6;
    const int wlast = (wq0 < q_hi) ? ((((wq0 + 31) < (q_hi - 1)) ? (wq0 + 31) : (q_hi - 1)) >> 6) : -1;
    bf16x8 qf[DQK / 16];
    { const int qrow = qpos < SL ? qpos : SL - 1;
#pragma unroll
      for (int st = 0; st < DQK / 16; ++st) { qf[st] = *(const bf16x8*)(Qh + (size_t)qrow * qpitch + mapi * DQK + 16 * st + 8 * hi);
          if (FAST && ALIBI) {
              u32x4 w = __builtin_bit_cast(u32x4, qf[st]);
#pragma unroll
              for (int e = 0; e < 4; ++e) w[e] = pk2(bflo(w[e]) * c1, bfhi(w[e]) * c1);
              qf[st] = __builtin_bit_cast(bf16x8, w); } } }
    f32x16 o[DV / 32];
#pragma unroll
    for (int d = 0; d < DV / 32; ++d) o[d] = f32x16{};
    float mrun = FAST ? 0.f : -INFINITY, lrun = 0.f;
    f32x16 negm = f32x16{}, osum = f32x16{};
    const bf16x8 ones8 = (bf16x8){0x3F80, 0x3F80, 0x3F80, 0x3F80, 0x3F80, 0x3F80, 0x3F80, 0x3F80};
    u32x4 kreg[KPT], vreg[VPT];
#define AT_LOAD(t) do { \
    _Pragma("unroll") for (int i_ = 0; i_ < KPT; ++i_) { const int c_ = tid + NT_BLK * i_; if (c_ < NKC) { const int key_ = c_ / KCH, ch_ = c_ - key_ * KCH; kreg[i_] = *(const u32x4*)(Kh + (size_t)((t) * 64 + key_) * kpitch + ch_ * 8); } } \
    _Pragma("unroll") for (int i_ = 0; i_ < VPT; ++i_) { const int c_ = tid + NT_BLK * i_; if (c_ < NVC) { const int key_ = c_ / VCH, ch_ = c_ - key_ * VCH; vreg[i_] = *(const u32x4*)(Vh + (size_t)((t) * 64 + key_) * vpitch + ch_ * 8); } } } while (0)
#define AT_STORE(kb, vs) do { \
    _Pragma("unroll") for (int i_ = 0; i_ < KPT; ++i_) { const int c_ = tid + NT_BLK * i_; if (c_ < NKC) { const int key_ = c_ / KCH, ch_ = c_ - key_ * KCH; *(LAS u32x4*)(lds + (kb) * KBYTES + key_ * KP + ch_ * 16) = kreg[i_]; } } \
    _Pragma("unroll") for (int i_ = 0; i_ < VPT; ++i_) { const int c_ = tid + NT_BLK * i_; if (c_ < NVC) { const int key_ = c_ / VCH, ch_ = c_ - key_ * VCH; *(LAS u32x4*)(lds + 2 * KBYTES + (vs) * VBYTES + key_ * VP + ch_ * 16) = vreg[i_]; } } } while (0)
    const bool late = wid >= 4;
    AT_LOAD(0); AT_STORE(0, 0);
    __syncthreads();
    const int vb = (4 * hi + ((lane & 15) >> 2)) * VP + (16 * ((lane >> 4) & 1) + 4 * (lane & 3)) * 2;
    bf16x8 pb[4];
#define AT_PV(vslot) do { const LAS unsigned char* vb_ = lds + 2 * KBYTES + (vslot) * VBYTES + vb; \
    _Pragma("unroll") for (int d = 0; d < DV / 32; ++d) _Pragma("unroll") for (int ks = 0; ks < 4; ++ks) { \
        const s16x4 lo_ = vtr(vb_ + (16 * ks) * VP + 64 * d), up_ = vtr(vb_ + (16 * ks + 8) * VP + 64 * d); \
        const bf16x8 a_ = (bf16x8){lo_[0], lo_[1], lo_[2], lo_[3], up_[0], up_[1], up_[2], up_[3]}; \
        o[d] = __builtin_amdgcn_mfma_f32_32x32x16_bf16(a_, pb[ks], o[d], 0, 0, 0); } \
    if (FAST) { _Pragma("unroll") for (int ks = 0; ks < 4; ++ks) osum = __builtin_amdgcn_mfma_f32_32x32x16_bf16(ones8, pb[ks], osum, 0, 0, 0); } } while (0)
    int vprev = 0, vcur = 0, vnext = 1;
    for (int t = 0; t < NT; ++t) {
        const int buf = t & 1;
        if (t + 1 < NT) AT_LOAD(t + 1);
        if (late && t >= 1 && t - 1 <= wlast) AT_PV(vprev);
        if (t <= wlast) {
            const LAS unsigned char* kb_ = lds + buf * KBYTES + r32 * KP + 16 * hi + mapi * (DQK * 2);
            f32x16 s0 = FAST ? negm : f32x16{}, s1 = FAST ? negm : f32x16{};
#pragma unroll
            for (int st = 0; st < DQK / 16; ++st) {
                const bf16x8 a0 = *(const LAS bf16x8*)(kb_ + 32 * st), a1 = *(const LAS bf16x8*)(kb_ + 32 * KP + 32 * st);
                s0 = __builtin_amdgcn_mfma_f32_32x32x16_bf16(a0, qf[st], s0, 0, 0, 0);
                s1 = __builtin_amdgcn_mfma_f32_32x32x16_bf16(a1, qf[st], s1, 0, 0, 0);
            }
            const int kbase = t * 64 + 4 * hi - qpos;
            if (ALIBI) {
                const float b0 = c2 * (float)kbase;
#pragma unroll
                for (int r = 0; r < 16; ++r) { const float kr = (float)((r & 3) + 8 * (r >> 2));
                    if (FAST) { s0[r] += fmaf(c2, kr, b0); s1[r] += fmaf(c2, kr + 32.f, b0); }
                    else { s0[r] = fmaf(s0[r], c1, fmaf(c2, kr, b0)); s1[r] = fmaf(s1[r], c1, fmaf(c2, kr + 32.f, b0)); } }
            }
            if (t * 64 + 63 > wq0) {
#pragma unroll
                for (int r = 0; r < 16; ++r) { const int dk = kbase + (r & 3) + 8 * (r >> 2); if (dk > 0) s0[r] = -INFINITY; if (dk + 32 > 0) s1[r] = -INFINITY; }
            }
            float mx = fmaxf(s0[0], s1[0]);
#pragma unroll
            for (int r = 1; r < 16; ++r) mx = fmaxf(fmaxf(mx, s0[r]), s1[r]);
            mx = xhalf_max(mx);
            if (FAST) {
                if (t == 0 || __any(mx > 8.f)) {
                    const float dl = (t == 0) ? mx : fmaxf(mx, 0.f);
                    mrun += dl;
#pragma unroll
                    for (int r = 0; r < 16; ++r) { s0[r] -= dl; s1[r] -= dl; negm[r] = -mrun; }
                    if (t != 0) { const float f = __builtin_amdgcn_exp2f(-dl);
#pragma unroll
                        for (int r = 0; r < 16; ++r) osum[r] *= f;
#pragma unroll
                        for (int d = 0; d < DV / 32; ++d)
#pragma unroll
                            for (int r = 0; r < 16; ++r) o[d][r] *= f; }
                }
#pragma unroll
                for (int r = 0; r < 16; ++r) { s0[r] = __builtin_amdgcn_exp2f(s0[r]); s1[r] = __builtin_amdgcn_exp2f(s1[r]); }
            } else {
            if (!ALIBI) mx *= c1;
            const float mn = fmaxf(mrun, mx);
            if (__any(mn != mrun)) {
                const float alpha = __builtin_amdgcn_exp2f(mrun - mn);
                lrun *= alpha;
#pragma unroll
                for (int d = 0; d < DV / 32; ++d)
#pragma unroll
                    for (int r = 0; r < 16; ++r) o[d][r] *= alpha;
                mrun = mn;
            }
            float ps = 0.f;
#pragma unroll
            for (int r = 0; r < 16; ++r) {
                if (ALIBI) { s0[r] = __builtin_amdgcn_exp2f(s0[r] - mn); s1[r] = __builtin_amdgcn_exp2f(s1[r] - mn); }
                else { s0[r] = __builtin_amdgcn_exp2f(fmaf(s0[r], c1, -mn)); s1[r] = __builtin_amdgcn_exp2f(fmaf(s1[r], c1, -mn)); }
                ps += s0[r] + s1[r]; }
            lrun += ps;
            }
            { u32x4 w;
              w.x = pk2(s0[0], s0[1]); w.y = pk2(s0[2], s0[3]); w.z = pk2(s0[4], s0[5]); w.w = pk2(s0[6], s0[7]); pb[0] = __builtin_bit_cast(bf16x8, w);
              w.x = pk2(s0[8], s0[9]); w.y = pk2(s0[10], s0[11]); w.z = pk2(s0[12], s0[13]); w.w = pk2(s0[14], s0[15]); pb[1] = __builtin_bit_cast(bf16x8, w);
              w.x = pk2(s1[0], s1[1]); w.y = pk2(s1[2], s1[3]); w.z = pk2(s1[4], s1[5]); w.w = pk2(s1[6], s1[7]); pb[2] = __builtin_bit_cast(bf16x8, w);
              w.x = pk2(s1[8], s1[9]); w.y = pk2(s1[10], s1[11]); w.z = pk2(s1[12], s1[13]); w.w = pk2(s1[14], s1[15]); pb[3] = __builtin_bit_cast(bf16x8, w); }
            if (!late) AT_PV(vcur);
        }
        if (t + 1 < NT) AT_STORE(buf ^ 1, vnext);
        __syncthreads();
        vprev = vcur; vcur = vnext; vnext = (vnext == 2) ? 0 : vnext + 1;
    }
    if (late && NT - 1 <= wlast) AT_PV(vprev);
    __syncthreads();
#undef AT_PV
#undef AT_LOAD
#undef AT_STORE
    const float ltot = FAST ? osum[0] : xhalf_sum(lrun), inv = 1.f / ltot;
    if (!DUAL) {
        if (qpos < q_hi) {
            bf16_t* op = Oh + (size_t)qpos * opitch + 4 * hi;
#pragma unroll
            for (int d = 0; d < DV / 32; ++d)
#pragma unroll
                for (int g4 = 0; g4 < 4; ++g4) { u32x2 w; w.x = pk2(o[d][4 * g4] * inv, o[d][4 * g4 + 1] * inv); w.y = pk2(o[d][4 * g4 + 2] * inv, o[d][4 * g4 + 3] * inv);
                    *(u32x2*)(op + 32 * d + 8 * g4) = w; }
        }
    } else {
        LAS f32x4* xo = (LAS f32x4*)lds + (wid & 3) * (DV / 8) * 64 + lane;
        if (wid >= 4) {
#pragma unroll
            for (int d = 0; d < DV / 32; ++d)
#pragma unroll
                for (int g4 = 0; g4 < 4; ++g4) xo[(4 * d + g4) * 64] = (f32x4){o[d][4 * g4] * inv, o[d][4 * g4 + 1] * inv, o[d][4 * g4 + 2] * inv, o[d][4 * g4 + 3] * inv};
        }
        __syncthreads();
        if (wid < 4) {
            float ss = 0.f;
#pragma unroll
            for (int d = 0; d < DV / 32; ++d)
#pragma unroll
                for (int g4 = 0; g4 < 4; ++g4) { const f32x4 o1 = xo[(4 * d + g4) * 64];
#pragma unroll
                    for (int j = 0; j < 4; ++j) { const float v = o[d][4 * g4 + j] * inv - lam * o1[j]; o[d][4 * g4 + j] = v; ss += v * v; } }
            ss = xhalf_sum(ss);
            const float rr = rsqrtf(ss * (1.f / DV) + EPS) * oscale;
            if (qpos < q_hi) {
                bf16_t* op = Oh + (size_t)qpos * opitch + 4 * hi;
#pragma unroll
                for (int d = 0; d < DV / 32; ++d)
#pragma unroll
                    for (int g4 = 0; g4 < 4; ++g4) { const f32x4 gg = *(const f32x4*)(gsub + 32 * d + 8 * g4 + 4 * hi);
                        u32x2 w; w.x = pk2(o[d][4 * g4] * rr * gg.x, o[d][4 * g4 + 1] * rr * gg.y); w.y = pk2(o[d][4 * g4 + 2] * rr * gg.z, o[d][4 * g4 + 3] * rr * gg.w);
                        *(u32x2*)(op + 32 * d + 8 * g4) = w; }
            }
        }
        __syncthreads();
    }
}

template <int MODE, int ABL = 0>
__device__ __forceinline__ void attn_phase(LAS unsigned char* lds, const bf16_t* Qb, const bf16_t* Kb, const bf16_t* Vb, bf16_t* Ob, int vcu, int G, int tid) {
    constexpr float L2E = 1.4426950408889634f;
    for (int flat = vcu; flat < 1024 + 128; flat += G) {
        int bh, ua, ub;
        if (flat < 1024) { const int f = flat & 255; bh = f >> 1; const int p = (f & 1) * 4 + (flat >> 8); ua = 16 - p; ub = 1 + p; }
        else { bh = flat - 1024; ua = 0; ub = -1; }
        const int b = bh >> 4, h = bh & 15;
        const size_t row0 = (size_t)b * SL;
#pragma unroll 1
        for (int k = 0; k < 2; ++k) {
            const int u = k ? ub : ua; if (u < 0) break;
            const int q_lo = u ? 16 + 256 * (u - 1) : 0, q_hi = u ? q_lo + 256 : 16;
            attn_unit<96, 64, false, false, true>(lds, Qb + row0 * 1536 + h * 96, 1536, Kb + row0 * 1536 + h * 96, 1536, Vb + row0 * 1024 + h * 64, 1024, Ob + row0 * 1024 + h * 64, 1024,
                                     q_lo, q_hi, 0.10206207261596577f * L2E, 0.f, tid);
        }
    }
}
__device__ __forceinline__ void diff_attn_phase(LAS unsigned char* lds, const bf16_t* QKV, bf16_t* Y, const float* lq1, const float* lk1, const float* lq2, const float* lk2, const float* gsub,
                                                float lambda_init, int vcu, int G, int tid) {
    constexpr float L2E = 1.4426950408889634f;
    const int lane = tid & 63;
    const float lam = __expf(wave_sum(lq1[lane] * lk1[lane], lane)) - __expf(wave_sum(lq2[lane] * lk2[lane], lane)) + lambda_init;
    for (int flat = vcu; flat < 1024 + 64; flat += G) {
        int bh, ua, ub;
        if (flat < 1024) { const int f = flat & 255; bh = f >> 2; const int p = (f & 3) * 4 + (flat >> 8); ua = 32 - p; ub = 1 + p; }
        else { bh = flat - 1024; ua = 0; ub = -1; }
        const int b = bh >> 3, h = bh & 7;
        const size_t row0 = (size_t)b * SL;
#pragma unroll 1
        for (int k = 0; k < 2; ++k) {
            const int u = k ? ub : ua; if (u < 0) break;
            const int q_lo = u ? 16 + 128 * (u - 1) : 0, q_hi = u ? q_lo + 128 : 16;
            attn_unit<64, 128, true, true, true>(lds, QKV + row0 * 3072 + h * 128, 3072, QKV + row0 * 3072 + 1024 + h * 128, 3072, QKV + row0 * 3072 + 2048 + h * 128, 3072, Y + row0 * 1024 + h * 128, 1024,
                                           q_lo, q_hi, 0.125f * L2E, exp2f(-(float)(h + 1)) * L2E, tid, lam, gsub, 1.f - lambda_init);
        }
    }
}

__device__ __forceinline__ void init_rows(const float* x, const float* meta, float* out, float* hm, const float* g0, bf16_t* XN, int gw, int NGW, int lane) {
    constexpr int RB = 4;
    for (int m0 = gw; m0 < MROWS; m0 += NGW * RB) {
        f32x4 v[RB][4];
#pragma unroll
        for (int k = 0; k < RB; ++k) { const int m = m0 + k * NGW, mc = m < MROWS ? m : MROWS - 1; const int b = mc / SL, t = mc - b * SL;
            const float* src = t < NMETA ? meta + (size_t)t * DM : x + ((size_t)b * SEQ + (t - NMETA)) * DM;
#pragma unroll
            for (int j = 0; j < 4; ++j) v[k][j] = __builtin_nontemporal_load((const f32x4*)(src + 4 * lane + 256 * j)); }
#pragma unroll
        for (int k = 0; k < RB; ++k) { const int m = m0 + k * NGW; if (m < MROWS) { float* h = hrow(out, hm, m);
#pragma unroll
            for (int j = 0; j < 4; ++j) __builtin_nontemporal_store(v[k][j], (f32x4*)(h + 4 * lane + 256 * j));
            rms_store_bf16(v[k], g0, XN + (size_t)m * DM, lane); } }
    }
}
__device__ __forceinline__ void nr_rows(const bf16_t* MO, float* out, float* hm, const float* ga, const float* gb, bf16_t* XN, int gw, int NGW, int lane) {
    constexpr int RB = 4;
    for (int m0 = gw; m0 < MROWS; m0 += NGW * RB) {
        float* h[RB]; u32x2 w[RB][4]; f32x4 hv[RB][4];
#pragma unroll
        for (int k = 0; k < RB; ++k) { const int m = m0 + k * NGW; const int mc = m < MROWS ? m : MROWS - 1; h[k] = hrow(out, hm, mc);
#pragma unroll
            for (int j = 0; j < 4; ++j) { w[k][j] = __builtin_nontemporal_load((const u32x2*)(MO + (size_t)mc * DM + 4 * lane + 256 * j)); hv[k][j] = __builtin_nontemporal_load((const f32x4*)(h[k] + 4 * lane + 256 * j)); } }
        float s[RB];
#pragma unroll
        for (int k = 0; k < RB; ++k) { s[k] = 0.f;
#pragma unroll
            for (int j = 0; j < 4; ++j) { const float a0 = bflo(w[k][j].x), a1 = bfhi(w[k][j].x), a2 = bflo(w[k][j].y), a3 = bfhi(w[k][j].y); s[k] += (a0 * a0 + a1 * a1) + (a2 * a2 + a3 * a3); } }
#pragma unroll
        for (int o = 1; o < 64; o <<= 1) {
#pragma unroll
            for (int k = 0; k < RB; ++k) s[k] += lane_xor(s[k], lane, o); }
        float s2[RB];
#pragma unroll
        for (int k = 0; k < RB; ++k) { const float r = rsqrtf(s[k] * (1.f / DM) + EPS); s2[k] = 0.f;
#pragma unroll
            for (int j = 0; j < 4; ++j) { const f32x4 gg = *(const f32x4*)(ga + 4 * lane + 256 * j);
                const f32x4 y = (f32x4){bflo(w[k][j].x), bfhi(w[k][j].x), bflo(w[k][j].y), bfhi(w[k][j].y)};
                hv[k][j] = hv[k][j] + y * r * gg;
                s2[k] += (hv[k][j].x * hv[k][j].x + hv[k][j].y * hv[k][j].y) + (hv[k][j].z * hv[k][j].z + hv[k][j].w * hv[k][j].w); } }
#pragma unroll
        for (int k = 0; k < RB; ++k) { if (m0 + k * NGW < MROWS) {
#pragma unroll
            for (int j = 0; j < 4; ++j) __builtin_nontemporal_store(hv[k][j], (f32x4*)(h[k] + 4 * lane + 256 * j)); } }
        if (gb) {
#pragma unroll
            for (int o = 1; o < 64; o <<= 1) {
#pragma unroll
                for (int k = 0; k < RB; ++k) s2[k] += lane_xor(s2[k], lane, o); }
#pragma unroll
            for (int k = 0; k < RB; ++k) { const int m = m0 + k * NGW; if (m < MROWS) { const float r2 = rsqrtf(s2[k] * (1.f / DM) + EPS);
#pragma unroll
                for (int j = 0; j < 4; ++j) { const f32x4 gg = *(const f32x4*)(gb + 4 * lane + 256 * j);
                    u32x2 ov; ov.x = pk2(hv[k][j].x * r2 * gg.x, hv[k][j].y * r2 * gg.y); ov.y = pk2(hv[k][j].z * r2 * gg.z, hv[k][j].w * r2 * gg.w);
                    *(u32x2*)(XN + (size_t)m * DM + 4 * lane + 256 * j) = ov; } } }
        }
    }
}
__device__ __forceinline__ void mla_norm_rows(const bf16_t* C, const float* gq, const float* gkv, const float* rope, bf16_t* NQ, bf16_t* NKV, bf16_t* Kb, int gw, int NGW, int lane) {
    constexpr int RB = 4;
    const f32x4 gg = *(const f32x4*)(gq + 4 * lane); const float gk0 = gkv[2 * lane], gk1 = gkv[2 * lane + 1];
    const int e = lane & 31, i = e & 15;
    for (int m0 = gw; m0 < MROWS; m0 += NGW * RB) {
        u32x2 wq[RB]; unsigned wk[RB]; unsigned short xs_[RB], xo_[RB]; float cs[RB], sn[RB];
#pragma unroll
        for (int k = 0; k < RB; ++k) { const int m = m0 + k * NGW, mc = m < MROWS ? m : MROWS - 1; const bf16_t* c = C + (size_t)mc * 512; const int t = mc % SL;
            wq[k] = *(const u32x2*)(c + 4 * lane); wk[k] = *(const unsigned*)(c + 256 + 2 * lane); xs_[k] = c[384 + e]; xo_[k] = c[384 + (e ^ 16)];
            cs[k] = rope[t * 32 + i]; sn[k] = rope[t * 32 + 16 + i]; }
        float sq[RB], skv[RB];
#pragma unroll
        for (int k = 0; k < RB; ++k) { const float a0 = bflo(wq[k].x), a1 = bfhi(wq[k].x), a2 = bflo(wq[k].y), a3 = bfhi(wq[k].y), b0 = bflo(wk[k]), b1 = bfhi(wk[k]);
            sq[k] = a0 * a0 + a1 * a1 + a2 * a2 + a3 * a3; skv[k] = b0 * b0 + b1 * b1; }
#pragma unroll
        for (int o = 1; o < 64; o <<= 1) {
#pragma unroll
            for (int k = 0; k < RB; ++k) { const float t1 = lane_xor(sq[k], lane, o), t2 = lane_xor(skv[k], lane, o); sq[k] += t1; skv[k] += t2; } }
#pragma unroll
        for (int k = 0; k < RB; ++k) { const int m = m0 + k * NGW; if (m < MROWS) {
            const float a0 = bflo(wq[k].x), a1 = bfhi(wq[k].x), a2 = bflo(wq[k].y), a3 = bfhi(wq[k].y), b0 = bflo(wk[k]), b1 = bfhi(wk[k]);
            const float r = rsqrtf(sq[k] * (1.f / 256.f) + EPS), r2 = rsqrtf(skv[k] * (1.f / 128.f) + EPS);
            u32x2 o; o.x = pk2(a0 * r * gg.x, a1 * r * gg.y); o.y = pk2(a2 * r * gg.z, a3 * r * gg.w); *(u32x2*)(NQ + (size_t)m * 256 + 4 * lane) = o;
            *(unsigned*)(NKV + (size_t)m * 256 + 2 * lane) = pk2(b0 * r2 * gk0, b1 * r2 * gk1);
            *(unsigned*)(NKV + (size_t)m * 256 + 128 + 2 * lane) = 0u;
            const float xs = bf2f(xs_[k]), xo = bf2f(xo_[k]);
            const float v = (e < 16) ? (xs * cs[k] - xo * sn[k]) : (xs * cs[k] + xo * sn[k]);
            const unsigned short vb = (unsigned short)pg8::f2bf(v);
            bf16_t* kr = Kb + (size_t)m * 1536 + 64 + e;
#pragma unroll
            for (int q = 0; q < 8; ++q) kr[((lane >> 5) + 2 * q) * 96] = vb; } }
    }
}
__device__ __forceinline__ void sc_rows(const bf16_t* T, const float* cw, bf16_t* Y, int gw, int NGW, int lane) {
    for (int m = gw; m < MROWS; m += NGW) {
        const int t = m % SL;
#pragma unroll
        for (int half = 0; half < 2; ++half) {
            const int col = 8 * lane + 512 * half;
            const bf16_t* p = T + (size_t)m * 3072 + col;
            const u32x4 gb = *(const u32x4*)p;
            u32x4 gc[3], uu[3];
#pragma unroll
            for (int k = 0; k < 3; ++k) { const bool ok = t >= k; const bf16_t* q = p - (ok ? (size_t)k * 3072 : 0);
                gc[k] = *(const u32x4*)(q + 1024); uu[k] = *(const u32x4*)(q + 2048); if (!ok) { gc[k] = (u32x4){0u, 0u, 0u, 0u}; } }
            float w[3][8];
#pragma unroll
            for (int k = 0; k < 3; ++k) { const f32x4 a = *(const f32x4*)(cw + k * DM + col), b2 = *(const f32x4*)(cw + k * DM + col + 4);
                w[k][0] = a.x; w[k][1] = a.y; w[k][2] = a.z; w[k][3] = a.w; w[k][4] = b2.x; w[k][5] = b2.y; w[k][6] = b2.z; w[k][7] = b2.w; }
            unsigned ow[4];
#pragma unroll
            for (int e2 = 0; e2 < 4; ++e2) {
                float r2[2];
#pragma unroll
                for (int q = 0; q < 2; ++q) { const int e = 2 * e2 + q; float acc = 0.f;
#pragma unroll
                    for (int k = 0; k < 3; ++k) { const float g = q ? bfhi(gc[k][e2]) : bflo(gc[k][e2]), u = q ? bfhi(uu[k][e2]) : bflo(uu[k][e2]); acc += w[2 - k][e] * (g * u); }
                    r2[q] = (q ? bfhi(gb[e2]) : bflo(gb[e2])) * acc; }
                ow[e2] = pk2(r2[0], r2[1]);
            }
            *(u32x4*)(Y + (size_t)m * DM + col) = (u32x4){ow[0], ow[1], ow[2], ow[3]};
        }
    }
}
__device__ __forceinline__ void diff_combine_rows(const bf16_t* O01, const float* lq1, const float* lk1, const float* lq2, const float* lk2, const float* gsub, float lambda_init, bf16_t* Y,
                                                  int gw, int NGW, int lane) {
    const float lam = __expf(wave_sum(lq1[lane] * lk1[lane], lane)) - __expf(wave_sum(lq2[lane] * lk2[lane], lane)) + lambda_init;
    const int head = lane >> 3, sub = lane & 7;
    float g[16];
#pragma unroll
    for (int i = 0; i < 16; ++i) g[i] = gsub[16 * sub + i] * (1.f - lambda_init);
    for (int m = gw; m < MROWS; m += NGW) {
        const bf16_t* p0 = O01 + (size_t)m * 2048 + (2 * head) * 128 + 16 * sub;
        const u32x4 a0 = __builtin_nontemporal_load((const u32x4*)p0), a1 = __builtin_nontemporal_load((const u32x4*)(p0 + 8)), b0 = __builtin_nontemporal_load((const u32x4*)(p0 + 128)), b1 = __builtin_nontemporal_load((const u32x4*)(p0 + 136));
        float d[16]; float s = 0.f;
#pragma unroll
        for (int i = 0; i < 4; ++i) {
            d[2 * i] = bflo(a0[i]) - lam * bflo(b0[i]); d[2 * i + 1] = bfhi(a0[i]) - lam * bfhi(b0[i]);
            d[8 + 2 * i] = bflo(a1[i]) - lam * bflo(b1[i]); d[8 + 2 * i + 1] = bfhi(a1[i]) - lam * bfhi(b1[i]); }
#pragma unroll
        for (int i = 0; i < 16; ++i) s += d[i] * d[i];
        s += lane_xor(s, lane, 1); s += lane_xor(s, lane, 2); s += lane_xor(s, lane, 4);
        const float r = rsqrtf(s * (1.f / 128.f) + EPS);
        u32x4 o0, o1;
#pragma unroll
        for (int i = 0; i < 4; ++i) { o0[i] = pk2(d[2 * i] * r * g[2 * i], d[2 * i + 1] * r * g[2 * i + 1]); o1[i] = pk2(d[8 + 2 * i] * r * g[8 + 2 * i], d[9 + 2 * i] * r * g[9 + 2 * i]); }
        bf16_t* q = Y + (size_t)m * DM + head * 128 + 16 * sub;
        *(u32x4*)q = o0; *(u32x4*)(q + 8) = o1;
    }
}

__device__ __forceinline__ void p0_prologue(LAS unsigned char* lds, bf16_t* Wb, float* rope, float* out, float* hm, bf16_t* XN, int gw, int NGW, int lane, int wave, int bx, int tid, int G) {
    const float* norms = INP(2);
    LAS float* scr = (LAS float*)(lds + wave * 16384);
    int cbase = 0;
        for (int j = 0; j < 2; ++j) {
            cvt_weight(INP(3) + (size_t)j * 1024 * 416, 1024, 416, Wb + W_MLA_IN + j * SZ_MLA_IN, 1024, 512, 0, scr, gw, NGW, lane, cbase);
            cvt_weight(INP(6) + (size_t)j * 256 * 1536, 256, 1536, Wb + W_MLA_UQ + j * SZ_MLA_UQ, 256, 1536, 0, scr, gw, NGW, lane, cbase);
            cvt_weight(INP(7) + (size_t)j * 128 * 2048, 128, 2048, Wb + W_MLA_UKV + j * SZ_MLA_UKV, 256, 2048, 0, scr, gw, NGW, lane, cbase);
            cvt_weight(INP(8) + (size_t)j * 1024 * 1024, 1024, 1024, Wb + W_MLA_O + j * SZ_SQ, 1024, 1024, 0, scr, gw, NGW, lane, cbase);
        }
        cvt_weight(INP(9), 1024, 3072, Wb + W_SC_IN, 1024, 3072, 0, scr, gw, NGW, lane, cbase);
        cvt_weight(INP(11), 1024, 1024, Wb + W_SC_OUT, 1024, 1024, 0, scr, gw, NGW, lane, cbase);
        cvt_weight(INP(12), 1024, 3072, Wb + W_DF_IN, 1024, 3072, 0, scr, gw, NGW, lane, cbase);
        cvt_weight(INP(18), 1024, 1024, Wb + W_DF_O, 1024, 1024, 0, scr, gw, NGW, lane, cbase);
        for (int i = 0; i < DEPTH; ++i) {
            cvt_weight(INP(19) + (size_t)i * 1024 * 5632, 1024, 5632, Wb + W_UP + i * SZ_UP, 1024, 5632, 1, scr, gw, NGW, lane, cbase);
            cvt_weight(INP(21) + (size_t)i * 2816 * 1024, 2816, 1024, Wb + W_DN + i * SZ_DN, 2816, 1024, 0, scr, gw, NGW, lane, cbase);
        }
        for (int idx = bx * NT_BLK + tid; idx < SL * 16; idx += G * NT_BLK) {
            const int pos = idx >> 4, i = idx & 15;
            const float invf = exp2f(-(float)(2 * i) * (13.287712379549449f / 32.f));
            const float ang = (float)pos * invf;
            double rev = (double)ang * 0.15915494309189535; rev -= floor(rev);
            const float rf = (float)rev;
            rope[pos * 32 + i] = __builtin_amdgcn_cosf(rf); rope[pos * 32 + 16 + i] = __builtin_amdgcn_sinf(rf);
        }
        init_rows(INP(0), INP(1), out, hm, norms, XN, gw, NGW, lane);
}

#define XB_TMO      128
#define XB_XCNT(j)  (256  + 64 * (j))
#define XB_XSUB(j)  (1280 + 64 * (j))
#define XB_XGEN(j)  (2304 + 64 * (j))
#define XB_TOP      3328
#define XB_TOPGEN   3392
#define XCD_BAR_WORDS 3456
#define XB_SPIN_CAP (1u << 18)
__device__ __forceinline__ unsigned xb_ld(unsigned* p)              { return __hip_atomic_load(p, __ATOMIC_RELAXED, __HIP_MEMORY_SCOPE_AGENT); }
__device__ __forceinline__ unsigned xb_add(unsigned* p, unsigned v) { return __hip_atomic_fetch_add(p, v, __ATOMIC_RELAXED, __HIP_MEMORY_SCOPE_AGENT); }
__device__ __forceinline__ unsigned xb_xcc_id() { return (unsigned)__builtin_amdgcn_s_getreg((3 << 11) | 20) & 0xFu; }
#define XB_SPIN(cond, bar) do { unsigned _sp = 0; while (cond) { __builtin_amdgcn_s_sleep(1); \
    if ((++_sp & 255u) == 0u) { if (xb_ld(&(bar)[XB_TMO])) break; if (_sp > XB_SPIN_CAP) { atomicAdd(&(bar)[XB_TMO], 1u); break; } } } } while (0)
struct XcdBarrier { unsigned* bar; unsigned x; volatile LAS unsigned* st; };
__device__ __forceinline__ XcdBarrier xcd_barrier_post(unsigned* bar, volatile LAS unsigned* st, int tid) {
    XcdBarrier b; b.bar = bar; b.x = xb_xcc_id(); b.st = st;
    if (tid == 0) (void)xb_add(&bar[XB_XCNT(b.x)], 1u);
    return b;
}
__device__ __forceinline__ void xcd_barrier_complete(unsigned* bar, unsigned x, unsigned& nloc, unsigned& nx) {
    const unsigned G = gridDim.x * gridDim.y * gridDim.z;
    unsigned sum, cnt, mine, sp = 0u;
    for (;;) {
        sum = 0u; cnt = 0u; mine = 0u;
#pragma unroll
        for (unsigned j = 0; j < 16; ++j) { const unsigned c = xb_ld(&bar[XB_XCNT(j)]); sum += c; cnt += (c > 0u) ? 1u : 0u; mine = (j == x) ? c : mine; }
        if (sum == G) break;
        __builtin_amdgcn_s_sleep(1);
        if ((++sp & 255u) == 0u) { if (xb_ld(&bar[XB_TMO])) break; if (sp > XB_SPIN_CAP) { atomicAdd(&bar[XB_TMO], 1u); break; } }
    }
    nloc = mine > 0u ? mine : 1u; nx = cnt > 0u ? cnt : 1u;
}
__device__ __forceinline__ void xcd_barrier(const XcdBarrier& b, int tid) {
    asm volatile("s_waitcnt vmcnt(0)" ::: "memory");
    __syncthreads();
    if (tid == 0) {
        unsigned* bar = b.bar; unsigned bx_ = b.x; asm volatile("" : "+s"(bx_));
        __builtin_amdgcn_s_waitcnt(0);
        unsigned nloc = b.st[0], nx = b.st[1];
        if (nloc == 0u) { xcd_barrier_complete(bar, bx_, nloc, nx); b.st[0] = nloc; b.st[1] = nx; }
        const unsigned old = xb_add(&bar[XB_XSUB(bx_)], 1u);
        const unsigned gen = old / nloc;
        if (old + 1u == (gen + 1u) * nloc) {
            __builtin_amdgcn_fence(__ATOMIC_RELEASE, "agent");
            asm volatile("s_waitcnt vmcnt(0)" ::: "memory");
            const unsigned og = xb_add(&bar[XB_TOP], 1u);
            const unsigned tg = og / nx;
            if (og + 1u == (tg + 1u) * nx) xb_add(&bar[XB_TOPGEN], 1u);
            else XB_SPIN(xb_ld(&bar[XB_TOPGEN]) == tg, bar);
            __builtin_amdgcn_fence(__ATOMIC_ACQUIRE, "agent");
            xb_add(&bar[XB_XGEN(bx_)], 1u);
            asm volatile("s_waitcnt vmcnt(0)" ::: "memory");
        } else {
            XB_SPIN(xb_ld(&bar[XB_XGEN(bx_)]) == gen, bar);
            __builtin_amdgcn_fence(__ATOMIC_ACQUIRE, "agent");
            asm volatile("s_waitcnt vmcnt(0)" ::: "memory");
        }
    }
    __syncthreads();
}
template <int K>
__device__ __forceinline__ void tail_gemm(LAS unsigned char* lds, const bf16_t* A, const bf16_t* Bt, int N, bf16_t* C, int ldc, int vcu, int G, int tid) {
    constexpr int ROW0 = 32768;
    const int lane = tid & 63, wave = __builtin_amdgcn_readfirstlane(tid >> 6), l16 = lane & 15, lq = lane >> 4;
    LAS float* red = (LAS float*)lds;
    const int ntn = N / 32, ntiles = 8 * ntn; constexpr int kw = K / 8, NS = kw / 32;
    for (int tile = vcu; tile < ntiles; tile += G) {
        const int tm = tile / ntn, tn = tile - tm * ntn;
        const bf16_t* ap = A + (size_t)(ROW0 + tm * 16 + l16) * K + wave * kw + 8 * lq;
        const bf16_t* bp = Bt + (size_t)(tn * 32 + l16) * K + wave * kw + 8 * lq;
        f32x4 c0 = (f32x4){0.f, 0.f, 0.f, 0.f}, c1 = c0;
        bf16x8 fa[NS], fb0[NS], fb1[NS];
#pragma unroll
        for (int s = 0; s < NS; ++s) { fa[s] = *(const bf16x8*)(ap + 32 * s); fb0[s] = *(const bf16x8*)(bp + 32 * s); fb1[s] = *(const bf16x8*)(bp + (size_t)16 * K + 32 * s); }
#pragma unroll
        for (int s = 0; s < NS; ++s) {
            c0 = __builtin_amdgcn_mfma_f32_16x16x32_bf16(fa[s], fb0[s], c0, 0, 0, 0);
            c1 = __builtin_amdgcn_mfma_f32_16x16x32_bf16(fa[s], fb1[s], c1, 0, 0, 0);
        }
#pragma unroll
        for (int e = 0; e < 4; ++e) { red[wave * 512 + (4 * lq + e) * 32 + l16] = c0[e]; red[wave * 512 + (4 * lq + e) * 32 + 16 + l16] = c1[e]; }
        __syncthreads();
        float s = 0.f;
#pragma unroll
        for (int w = 0; w < 8; ++w) s += red[w * 512 + tid];
        C[(size_t)(ROW0 + tm * 16 + (tid >> 5)) * ldc + tn * 32 + (tid & 31)] = (bf16_t)pg8::f2bf(s);
        __syncthreads();
    }
}
__device__ __forceinline__ int lane_id_opaque() { int l; asm volatile("v_mbcnt_lo_u32_b32 %0, -1, 0\n\tv_mbcnt_hi_u32_b32 %0, -1, %0" : "=v"(l)); return l; }
constexpr int N_PHASES = 33;
#define RPT_1(...) __VA_ARGS__
#define RPT_2(...) __VA_ARGS__ __VA_ARGS__
#define RPT_CAT(a, b) a##b
#define RPT_X(n, ...) RPT_CAT(RPT_, n)(__VA_ARGS__)
#define RPT(n, ...) RPT_X(n, __VA_ARGS__)
#ifndef PROBE_ABL
#define PROBE_ABL -1
#endif
#ifndef REP_ROWS
#define REP_ROWS 1
#endif
#ifndef REP_ATTN
#define REP_ATTN 1
#endif
#ifndef REP_UP
#define REP_UP 1
#endif
#ifndef REP_DN
#define REP_DN 1
#endif
#ifndef REP_MIX
#define REP_MIX 1
#endif
__global__ void __launch_bounds__(NT_BLK, 2) trunk_fwd(Args args) {
    extern __shared__ __attribute__((aligned(16))) unsigned char lds_raw[];
    LAS unsigned char* lds = (LAS unsigned char*)lds_raw;
    unsigned long long wsi = (unsigned long long)args.ws, outi = (unsigned long long)args.out;
#if MK_MULTI
    const int lo = args.ph_lo, hi = args.ph_hi;
#else
    constexpr int lo = 0, hi = N_PHASES;
#endif
    int ph = 0;
    const int wave0 = __builtin_amdgcn_readfirstlane((int)threadIdx.x >> 6);
#define MY_TID() (wave0 * 64 + lane_id_opaque())
#if !MK_MULTI
    volatile LAS unsigned* bst = (volatile LAS unsigned*)(lds + 131072);
    { const int t0 = MY_TID(); if (t0 < 4) bst[t0] = 0u; __syncthreads(); }
    const XcdBarrier xbar = xcd_barrier_post((unsigned*)args.ws, bst, MY_TID());
#endif
#define PH_BEGIN if (lo <= ph && ph < hi) { \
    int tid = MY_TID(), bx = blockIdx.x, G = gridDim.x; asm volatile("" : "+v"(tid), "+s"(bx), "+s"(G), "+s"(wsi), "+s"(outi)); unsigned char* ws = (unsigned char*)(GASP unsigned char*)wsi; float* out = (float*)(GASP float*)outi; \
    const int lane = tid & 63, wave = __builtin_amdgcn_readfirstlane(tid >> 6); \
    const int vcu = (G % 8 == 0) ? (bx % 8) * (G / 8) + bx / 8 : bx; const int gw = vcu * NW + wave, NGW = G * NW; \
    float* hm = (float*)(ws + WS_HM); float* rope = (float*)(ws + WS_ROPE); bf16_t* Wb = (bf16_t*)(ws + WS_W); bf16_t* XN = (bf16_t*)(ws + WS_XN); bf16_t* MO = (bf16_t*)(ws + WS_MO); unsigned char* R = ws + WS_R; \
    const float* norms = INP(2); (void)lane; (void)vcu; (void)gw; (void)NGW; (void)hm; (void)rope; (void)Wb; (void)XN; (void)MO; (void)R; (void)norms; (void)tid;
#if MK_MULTI
#define PH_END } ++ph;
#else
#define PH_END if (ph + 1 < hi) { if (ph == 0) cg::this_grid().sync(); else xcd_barrier(xbar, tid); } } ++ph;
#endif
#define GEMM(EPI, AOVF, Aptr, Btptr, KK, nM_, nN_, Eobj) do { pg8::Gemm g_{(const bf16_t*)(Aptr), (const bf16_t*)(Btptr), (KK)}; pg8::StaticOrder S_; S_.init((nM_), (nN_), G, bx); \
        pg8::gemm_phase<EPI, pg8::StaticOrder, AOVF>(lds, g_, S_, Eobj, tid); } while (0)

#define GEMM_T(Aptr, Btptr, KK, nN_, Cptr, ldc_) do { pg8::EpiBf16 E_{(bf16_t*)(Cptr), (ldc_)}; GEMM(pg8::EpiBf16, false, Aptr, Btptr, KK, 128, nN_, E_); \
        tail_gemm<KK>(lds, (const bf16_t*)(Aptr), (const bf16_t*)(Btptr), (nN_) * 256, (bf16_t*)(Cptr), (ldc_), vcu, G, tid); } while (0)
    PH_BEGIN RPT(REP_ROWS, p0_prologue(lds, Wb, rope, out, hm, XN, gw, NGW, lane, wave, bx, tid, G);) PH_END

    for (int layer = 0; layer < DEPTH; ++layer) {
        const int kind = layer % 3, j = layer / 3;
#define nrm (norms + (size_t)layer * 4 * DM)
        if (kind == 0) {
            PH_BEGIN RPT(REP_MIX, { GEMM_T(XN, Wb + W_MLA_IN + j * SZ_MLA_IN, 1024, 2, (bf16_t*)(R + R_C), 512); }) PH_END
            PH_BEGIN RPT(REP_ROWS, mla_norm_rows((const bf16_t*)(R + R_C), INP(4) + j * 256, INP(5) + j * 128, rope, (bf16_t*)(R + R_NQ), (bf16_t*)(R + R_NKV), (bf16_t*)(R + R_K), gw, NGW, lane);) PH_END
            PH_BEGIN RPT(REP_MIX, { pg8::EpiMlaQ E{(bf16_t*)(R + R_Q), rope}; GEMM(pg8::EpiMlaQ, false, R + R_NQ, Wb + W_MLA_UQ + j * SZ_MLA_UQ, 256, NM, 6, E); } { pg8::EpiMlaKV E{(bf16_t*)(R + R_K), MO}; GEMM(pg8::EpiMlaKV, false, R + R_NKV, Wb + W_MLA_UKV + j * SZ_MLA_UKV, 256, NM, 8, E); }) PH_END
            PH_BEGIN attn_phase<0>(lds, (const bf16_t*)(R + R_Q), (const bf16_t*)(R + R_K), MO, XN, vcu, G, tid); PH_END
            PH_BEGIN RPT(REP_MIX, { GEMM_T(XN, Wb + W_MLA_O + j * SZ_SQ, 1024, 4, MO, 1024); }) PH_END
        } else if (kind == 1) {
            PH_BEGIN RPT(REP_MIX, { GEMM_T(XN, Wb + W_SC_IN, 1024, 12, (bf16_t*)R, 3072); }) PH_END
            PH_BEGIN RPT(REP_ROWS, sc_rows((const bf16_t*)R, INP(10), XN, gw, NGW, lane);) PH_END
            PH_BEGIN RPT(REP_MIX, { GEMM_T(XN, Wb + W_SC_OUT, 1024, 4, MO, 1024); }) PH_END
        } else {
            const float lambda_init = 0.8f - 0.6f * __expf(-0.3f * (float)layer);
            PH_BEGIN RPT(REP_MIX, { GEMM_T(XN, Wb + W_DF_IN, 1024, 12, (bf16_t*)R, 3072); }) PH_END
            PH_BEGIN diff_attn_phase(lds, (const bf16_t*)R, XN, INP(13), INP(14), INP(15), INP(16), INP(17), lambda_init, vcu, G, tid); PH_END
            PH_BEGIN RPT(REP_MIX, { GEMM_T(XN, Wb + W_DF_O, 1024, 4, MO, 1024); }) PH_END
        }
        PH_BEGIN nr_rows(MO, out, hm, nrm + DM, nrm + 2 * DM, XN, gw, NGW, lane); PH_END
        PH_BEGIN RPT(REP_UP, { pg8::EpiFfnUp E{(bf16_t*)R, INP(20) + (size_t)layer * 3 * 5632, MROWS}; GEMM(pg8::EpiFfnUp, true, XN - 2 * DM, Wb + W_UP + layer * SZ_UP, 1024, NM_UP, 22, E); }) PH_END
        PH_BEGIN RPT(REP_DN, { GEMM_T(R, Wb + W_DN + layer * SZ_DN, 2816, 4, MO, 1024); }) PH_END
        PH_BEGIN nr_rows(MO, out, hm, nrm + 3 * DM, (layer + 1 < DEPTH) ? norms + (size_t)(layer + 1) * 4 * DM : nullptr, XN, gw, NGW, lane); PH_END
    }
#undef nrm
#undef PH_BEGIN
#undef PH_END
#undef GEMM
#undef GEMM_T
}

extern "C" void kernel_launch(void* const* d_in, const int* in_sizes, int n_in, void* d_out, int out_size, void* d_ws, size_t ws_size, hipStream_t stream) {
    static int grid = 0;
    if (grid == 0) {
        if (n_in != 22 || out_size != NB * SEQ * DM || ws_size < WS_END) { fprintf(stderr, "kernel_launch: unexpected shapes (n_in %d, out %d, ws %zu < %zu); nothing launched\n", n_in, out_size, ws_size, (size_t)WS_END); grid = -1; return; }
        int dev = 0, cus = 0, per_cu = 0;
        if (hipGetDevice(&dev) != hipSuccess || hipDeviceGetAttribute(&cus, hipDeviceAttributeMultiprocessorCount, dev) != hipSuccess) { grid = -1; return; }
        if (hipFuncSetAttribute((const void*)trunk_fwd, hipFuncAttributeMaxDynamicSharedMemorySize, LDS_BYTES) != hipSuccess) { fprintf(stderr, "kernel_launch: hipFuncSetAttribute failed\n"); grid = -1; return; }
        if (hipOccupancyMaxActiveBlocksPerMultiprocessor(&per_cu, (const void*)trunk_fwd, NT_BLK, LDS_BYTES) != hipSuccess || per_cu < 1) { fprintf(stderr, "kernel_launch: occupancy query says %d\n", per_cu); per_cu = 1; }
        (void)hipGetLastError();
        grid = cus;
    }
    if (grid < 0) return;
    Args a{};
    for (int i = 0; i < 22; ++i) a.in[i] = (const float*)d_in[i];
    a.out = (float*)d_out; a.ws = (unsigned char*)d_ws;
#if MK_MULTI
    for (int p = 0; p < N_PHASES; ++p) { a.ph_lo = p; a.ph_hi = p + 1; hipLaunchKernelGGL(trunk_fwd, dim3(grid), dim3(NT_BLK), LDS_BYTES, stream, a); }
#else
    a.ph_lo = 0; a.ph_hi = N_PHASES;
    if (hipMemsetAsync(d_ws, 0, 16384, stream) != hipSuccess) { fprintf(stderr, "kernel_launch: memset of the barrier words failed\n"); return; }
    void* kargs[] = {&a};
    hipError_t e = hipLaunchCooperativeKernel((const void*)trunk_fwd, dim3(grid), dim3(NT_BLK), kargs, LDS_BYTES, stream);
    if (e != hipSuccess) fprintf(stderr, "kernel_launch: cooperative launch failed: %s (grid %d)\n", hipGetErrorString(e), grid);
#endif
}
```

```cpp
#include <hip/hip_runtime.h>
#include <hip/hip_cooperative_groups.h>
#include <cstdio>
#include <cstdint>
namespace cg = cooperative_groups;

#ifndef MK_MULTI
#define MK_MULTI 0
#endif

namespace pg8 {
#define PG8_LAS __attribute__((address_space(3)))
typedef unsigned short bf16_t;
typedef short bf16x8 __attribute__((ext_vector_type(8)));
typedef float f32x4 __attribute__((ext_vector_type(4)));
typedef unsigned u32x4 __attribute__((ext_vector_type(4)));
typedef unsigned u32x2 __attribute__((ext_vector_type(2)));
constexpr int BM = 256, BK = 64, HALF = 128, HTB = HALF * BK * 2  , STAGE_BYTES = 8 * HTB, NXCD = 8, WGM = 8;

__host__ __device__ __forceinline__ int lds_byte(int r, int c) { const int st = (r >> 4) * 2 + (c >> 5), rr = r & 15, cc = c & 31, ob = rr * 64 + cc * 2; return st * 1024 + (ob ^ (((ob >> 9) & 1) << 5)); }
__host__ __device__ __forceinline__ void stage_rc(int b, int& R, int& C) { const int st = b / 1024, sb = b % 1024, swz = sb ^ (((sb >> 9) & 1) << 5); R = (st >> 1) * 16 + swz / 64; C = (st & 1) * 32 + (swz % 64) / 2; }
__host__ __device__ __forceinline__ int perm32(int rho) { const int n = rho >> 4, i = rho & 15; return 8 * (i >> 2) + 4 * n + (i & 3); }

struct Unit { int pm, pn; };
struct Gemm { const bf16_t* A; const bf16_t* Bt; int K; };

struct StaticOrder {
    int nM, nN, nwg, G, c;
    __host__ __device__ void init(int nM_, int nN_, int G_, int c_) { nM = nM_; nN = nN_; nwg = nM * nN; G = G_; c = c_; }
    __host__ __device__ bool next(int i, Unit& u) const {
        const long L = (long)i * G + c; if (L >= nwg) return false;
        int wgid = (int)L; { const int q = nwg / NXCD, r = nwg % NXCD, xcd = wgid % NXCD, off = wgid / NXCD; wgid = (xcd < r ? xcd * (q + 1) : r * (q + 1) + (xcd - r) * q) + off; }
        const int nig = WGM * nN, gid = wgid / nig, fm = gid * WGM, gsz = (nM - fm) < WGM ? (nM - fm) : WGM;
        u.pm = fm + ((wgid % nig) % gsz); u.pn = (wgid % nig) / gsz; return true;
    }
};

__device__ __forceinline__ unsigned cvt_pk_bf16(float lo, float hi) { unsigned r; asm volatile("v_cvt_pk_bf16_f32 %0, %1, %2" : "=v"(r) : "v"(lo), "v"(hi)); return r; }

struct EpiBf16 {
    static constexpr bool PERM = true;
    bf16_t* O; int ldc;
    __device__ __forceinline__ void operator()(const f32x4 (&acc)[2][2][4][2], const Unit& u, int wr, int wc, int fr, int fq) const {
        const int row0 = u.pm * BM + wr * 64 + fr; const int col0 = u.pn * BM + wc * 32 + 8 * fq;
#pragma unroll
        for (int ai = 0; ai < 2; ++ai)
#pragma unroll
            for (int m = 0; m < 4; ++m) { bf16_t* rowp = O + (size_t)(row0 + ai * HALF + m * 16) * ldc + col0;
#pragma unroll
                for (int bj = 0; bj < 2; ++bj) { const f32x4 v0 = acc[ai][bj][m][0], v1 = acc[ai][bj][m][1];
                    u32x4 w; w.x = cvt_pk_bf16(v0[0], v0[1]); w.y = cvt_pk_bf16(v0[2], v0[3]); w.z = cvt_pk_bf16(v1[0], v1[1]); w.w = cvt_pk_bf16(v1[2], v1[3]);
                    *(u32x4*)(rowp + bj * HALF) = w; } }
    }
};
template <class Epi, class Sched, bool AOV = false>
__device__ __forceinline__ void gemm_phase(PG8_LAS unsigned char* lds, const Gemm g, const Sched& S, const Epi& E, int tid_in) {
    int tid_ = tid_in; asm volatile("" : "+v"(tid_));
    const int tid = tid_, wid = __builtin_amdgcn_readfirstlane(tid >> 6), lane = tid & 63, wr = wid >> 2, wc = wid & 3, fr = lane & 15, fq = lane >> 4;
    const int K = g.K, nt = K / BK;
    unsigned voffA[2], voffB[2];
#pragma unroll
    for (int i = 0; i < 2; ++i) { int R, C; stage_rc(tid * 16 + i * 8192, R, C); const int Rb = Epi::PERM ? ((R & ~31) + perm32(R & 31)) : R;
        voffA[i] = (unsigned)((AOV ? (R - 2 * (R >> 6)) : R) * K + C) * 2u; voffB[i] = (unsigned)(Rb * K + C) * 2u; }
    const size_t kstep = (size_t)(BK * 2);
    const size_t hstepB = (size_t)HALF * K * 2, hstepA = (size_t)(AOV ? 124 : HALF) * K * 2;
    const size_t tstepA = 2 * hstepA, tstepB = 2 * hstepB;
    const unsigned ldsw = (unsigned)wid * 1024u;
    const int aoff = lds_byte(wr * 64 + fr, fq * 8), boff = lds_byte(wc * 32 + fr, fq * 8);
#define PG8_SA(b, h) (((b) * 2 + (h)) * HTB)
#define PG8_SB(b, h) ((4 + (b) * 2 + (h)) * HTB)
#define PG8_STAGE(bufoff, gbase, voff) do { _Pragma("unroll") for (int _i = 0; _i < 2; ++_i) \
        __builtin_amdgcn_global_load_lds((const unsigned*)((const char*)(gbase) + (voff)[_i]), (PG8_LAS unsigned*)(lds + (bufoff) + ldsw + _i * 8192), 16, 0, 0); } while (0)
#define PG8_LDA(dst, b, h) do { _Pragma("unroll") for (int m = 0; m < 4; ++m) _Pragma("unroll") for (int k = 0; k < 2; ++k) dst[m][k] = *(const PG8_LAS bf16x8*)(lds + PG8_SA(b, h) + aoff + m * 2048 + k * 1024); } while (0)
#define PG8_LDB(dst, b, h) do { _Pragma("unroll") for (int n = 0; n < 2; ++n) _Pragma("unroll") for (int k = 0; k < 2; ++k) dst[n][k] = *(const PG8_LAS bf16x8*)(lds + PG8_SB(b, h) + boff + n * 2048 + k * 1024); } while (0)
#define PG8_MMA(ai, bj, At, Bt) do { __builtin_amdgcn_s_setprio(1); _Pragma("unroll") for (int m = 0; m < 4; ++m) _Pragma("unroll") for (int n = 0; n < 2; ++n) _Pragma("unroll") for (int k = 0; k < 2; ++k) \
        acc[ai][bj][m][n] = __builtin_amdgcn_mfma_f32_16x16x32_bf16(Bt[n][k], At[m][k], acc[ai][bj][m][n], 0, 0, 0); __builtin_amdgcn_s_setprio(0); } while (0)
#define PG8_WAIT_V(n) asm volatile("s_waitcnt vmcnt(" #n ")" ::: "memory")
#define PG8_WAIT_L(n) asm volatile("s_waitcnt lgkmcnt(" #n ")" ::: "memory")
#define PG8_BAR __builtin_amdgcn_s_barrier()
#define PG8_SCHED __builtin_amdgcn_sched_barrier(0)
    Unit cur, nxt; int ui = 0;
    if (!S.next(0, cur)) return;
    f32x4 acc[2][2][4][2];
#pragma unroll
    for (int a = 0; a < 2; ++a)
#pragma unroll
        for (int b = 0; b < 2; ++b)
#pragma unroll
            for (int m = 0; m < 4; ++m)
#pragma unroll
                for (int n = 0; n < 2; ++n) acc[a][b][m][n] = (f32x4){0.f, 0.f, 0.f, 0.f};
    bf16x8 At[4][2], B0[2][2], B1[2][2];
    const char* cA = (const char*)g.A + (size_t)cur.pm * tstepA; const char* cB = (const char*)g.Bt + (size_t)cur.pn * tstepB;
    PG8_STAGE(PG8_SB(0, 0), cB, voffB); PG8_STAGE(PG8_SA(0, 0), cA, voffA); PG8_STAGE(PG8_SB(0, 1), cB + hstepB, voffB); PG8_STAGE(PG8_SA(0, 1), cA + hstepA, voffA);
    if (wr == 1) PG8_BAR;
    PG8_WAIT_V(4); PG8_BAR;
    PG8_STAGE(PG8_SB(1, 0), cB + kstep, voffB); PG8_STAGE(PG8_SA(1, 0), cA + kstep, voffA); PG8_STAGE(PG8_SB(1, 1), cB + hstepB + kstep, voffB);
    PG8_WAIT_V(6); PG8_BAR;
    for (;;) {
        const bool has_next = S.next(ui + 1, nxt);
        const char* nA = has_next ? (const char*)g.A + (size_t)nxt.pm * tstepA : cA; const char* nB = has_next ? (const char*)g.Bt + (size_t)nxt.pn * tstepB : cB;
        for (int t = 0; t < nt; t += 2) {
            const bool last = (t == nt - 2);
            const char* a1 = cA + (size_t)(t + 1) * kstep;
            const char* a2 = last ? nA : cA + (size_t)(t + 2) * kstep; const char* b2 = last ? nB : cB + (size_t)(t + 2) * kstep;
            const char* a3 = a2 + kstep; const char* b3 = b2 + kstep;
            PG8_LDB(B0, 0, 0); PG8_SCHED; PG8_LDA(At, 0, 0); PG8_STAGE(PG8_SA(1, 1), a1 + hstepA, voffA);
            PG8_WAIT_L(8); PG8_BAR; PG8_WAIT_L(0); PG8_MMA(0, 0, At, B0); PG8_BAR; PG8_SCHED;
            PG8_LDB(B1, 0, 1); PG8_STAGE(PG8_SB(0, 0), b2, voffB);
            PG8_BAR; PG8_WAIT_L(0); PG8_MMA(0, 1, At, B1); PG8_BAR;
            PG8_LDA(At, 0, 1); PG8_STAGE(PG8_SA(0, 0), a2, voffA);
            PG8_BAR; PG8_WAIT_L(0); PG8_MMA(1, 0, At, B0); PG8_BAR; PG8_SCHED;
            PG8_STAGE(PG8_SB(0, 1), b2 + hstepB, voffB);
            PG8_WAIT_V(6); PG8_BAR; PG8_MMA(1, 1, At, B1); PG8_BAR;
            PG8_LDB(B0, 1, 0); PG8_SCHED; PG8_LDA(At, 1, 0); PG8_STAGE(PG8_SA(0, 1), a2 + hstepA, voffA);
            PG8_WAIT_L(8); PG8_BAR; PG8_WAIT_L(0); PG8_MMA(0, 0, At, B0); PG8_BAR; PG8_SCHED;
            PG8_LDB(B1, 1, 1); PG8_STAGE(PG8_SB(1, 0), b3, voffB);
            PG8_BAR; PG8_WAIT_L(0); PG8_MMA(0, 1, At, B1); PG8_BAR;
            PG8_LDA(At, 1, 1); PG8_STAGE(PG8_SA(1, 0), a3, voffA);
            PG8_BAR; PG8_WAIT_L(0); PG8_MMA(1, 0, At, B0); PG8_BAR; PG8_SCHED;
            PG8_STAGE(PG8_SB(1, 1), b3 + hstepB, voffB);
            PG8_WAIT_V(6); PG8_BAR; PG8_MMA(1, 1, At, B1); PG8_BAR;
        }
        E(acc, cur, wr, wc, fr, fq);
        if (!has_next) break;
#pragma unroll
        for (int a = 0; a < 2; ++a)
#pragma unroll
            for (int b = 0; b < 2; ++b)
#pragma unroll
                for (int m = 0; m < 4; ++m)
#pragma unroll
                    for (int n = 0; n < 2; ++n) acc[a][b][m][n] = (f32x4){0.f, 0.f, 0.f, 0.f};
        cur = nxt; cA = nA; cB = nB; ++ui;
    }
    PG8_WAIT_V(0);
    if (wr == 0) PG8_BAR;
    PG8_BAR;
#undef PG8_SA
#undef PG8_SB
#undef PG8_STAGE
#undef PG8_LDA
#undef PG8_LDB
#undef PG8_MMA
#undef PG8_WAIT_V
#undef PG8_WAIT_L
#undef PG8_BAR
#undef PG8_SCHED
}
}


namespace pg8 {
constexpr int SEQ_L = 4112;
template <int CTRL> __device__ __forceinline__ float dppf(float v) { return __builtin_bit_cast(float, __builtin_amdgcn_update_dpp(0, __builtin_bit_cast(int, v), CTRL, 0xf, 0xf, true)); }
template <int CTRL> __device__ __forceinline__ float dppo(float old, float v) { return __builtin_bit_cast(float, __builtin_amdgcn_update_dpp(__builtin_bit_cast(int, old), __builtin_bit_cast(int, v), CTRL, 0xf, 0xf, false)); }
__device__ __forceinline__ unsigned f2bf(float f) { unsigned u = __builtin_bit_cast(unsigned, f); return (u + 0x7fffu + ((u >> 16) & 1u)) >> 16; }
typedef float f32x2_t __attribute__((ext_vector_type(2))); typedef __bf16 bf16x2_t __attribute__((ext_vector_type(2)));
__device__ __forceinline__ unsigned pk2(float lo, float hi) { f32x2_t v = {lo, hi}; bf16x2_t b = __builtin_convertvector(v, bf16x2_t); return __builtin_bit_cast(unsigned, b); }

constexpr float QK_SCALE_L2E = 0.10206207261596577f * 1.4426950408889634f;
struct EpiMlaQ {
    static constexpr bool PERM = false;
    bf16_t* Q; const float* rope;
    __device__ __forceinline__ void operator()(const f32x4 (&acc)[2][2][4][2], const Unit& u, int wr, int wc, int fr, int fq) const {
#pragma unroll
        for (int ai = 0; ai < 2; ++ai)
#pragma unroll
            for (int m = 0; m < 4; ++m) {
                const int row = u.pm * BM + ai * HALF + wr * 64 + m * 16 + fr;
                const int t = row % SEQ_L;
                const f32x4 cs = *(const f32x4*)(rope + t * 32 + 4 * fq), sn = *(const f32x4*)(rope + t * 32 + 16 + 4 * fq);
#pragma unroll
                for (int bj = 0; bj < 2; ++bj) {
                    const int c32 = u.pn * BM + bj * HALF + wc * 32;
                    f32x4 v0 = acc[ai][bj][m][0], v1 = acc[ai][bj][m][1];
                    if (((c32 >> 5) % 3) == 2) { const f32x4 x1 = v0, x2 = v1; v0 = x1 * cs - x2 * sn; v1 = x2 * cs + x1 * sn; }
                    v0 *= QK_SCALE_L2E; v1 *= QK_SCALE_L2E;
                    bf16_t* p = Q + (size_t)row * 1536 + c32 + 4 * fq;
                    u32x2 w0, w1; w0.x = pk2(v0[0], v0[1]); w0.y = pk2(v0[2], v0[3]); w1.x = pk2(v1[0], v1[1]); w1.y = pk2(v1[2], v1[3]);
                    *(u32x2*)p = w0; *(u32x2*)(p + 16) = w1;
                }
                asm volatile("" ::: "memory");
            }
    }
};
struct EpiMlaKV {
    static constexpr bool PERM = false;
    bf16_t* Kb; bf16_t* Vb;
    __device__ __forceinline__ void operator()(const f32x4 (&acc)[2][2][4][2], const Unit& u, int wr, int wc, int fr, int fq) const {
#pragma unroll
        for (int ai = 0; ai < 2; ++ai)
#pragma unroll
            for (int m = 0; m < 4; ++m) {
                const int row = u.pm * BM + ai * HALF + wr * 64 + m * 16 + fr;
#pragma unroll
                for (int bj = 0; bj < 2; ++bj) {
                    const int head = u.pn * 2 + bj;
                    bf16_t* p = (wc < 2) ? (Kb + (size_t)row * 1536 + head * 96 + wc * 32 + 4 * fq) : (Vb + (size_t)row * 1024 + head * 64 + (wc - 2) * 32 + 4 * fq);
                    const f32x4 v0 = acc[ai][bj][m][0], v1 = acc[ai][bj][m][1];
                    u32x2 w0, w1; w0.x = pk2(v0[0], v0[1]); w0.y = pk2(v0[2], v0[3]); w1.x = pk2(v1[0], v1[1]); w1.y = pk2(v1[2], v1[3]);
                    *(u32x2*)p = w0; *(u32x2*)(p + 16) = w1;
                }
            }
    }
};
struct EpiFfnUp {
    static constexpr bool PERM = false;
    bf16_t* ACT; const float* cw; int Mrows;
    __device__ __forceinline__ void operator()(const f32x4 (&acc)[2][2][4][2], const Unit& u, int wr, int wc, int fr, int fq) const {
#pragma unroll
        for (int n = 0; n < 2; ++n) {
            const int col = u.pn * 128 + wc * 32 + n * 16 + 4 * fq;
            const f32x4 g0 = *(const f32x4*)(cw + col), g1 = *(const f32x4*)(cw + 5632 + col), g2 = *(const f32x4*)(cw + 2 * 5632 + col);
            const f32x4 u0 = *(const f32x4*)(cw + 2816 + col), u1 = *(const f32x4*)(cw + 5632 + 2816 + col), u2 = *(const f32x4*)(cw + 2 * 5632 + 2816 + col);
#pragma unroll
            for (int ai = 0; ai < 2; ++ai)
#pragma unroll
                for (int m = 0; m < 4; ++m) {
                    const int grow = u.pm * 248 + ai * 124 + wr * 62 + m * 16 + fr - 2;
                    const int t = (grow + SEQ_L) % SEQ_L;
                    const bool ok = (m * 16 + fr >= 2) && grow < Mrows;
                    const bool edge = __any(t <= 1);
                    float r[4];
#pragma unroll
                    for (int j = 0; j < 4; ++j) {
                        const float gc = acc[ai][0][m][n][j], uc = acc[ai][1][m][n][j];
                        float go1 = 0.f, go2 = 0.f, uo1 = 0.f, uo2 = 0.f;
                        if (m > 0) { const float gq = acc[ai][0][m - 1][n][j], uq = acc[ai][1][m - 1][n][j];
                            go1 = dppf<0x10F>(gq); go2 = dppf<0x10E>(gq); uo1 = dppf<0x10F>(uq); uo2 = dppf<0x10E>(uq); }
                        float gp1 = dppo<0x111>(go1, gc), gp2 = dppo<0x112>(go2, gc), up1 = dppo<0x111>(uo1, uc), up2 = dppo<0x112>(uo2, uc);
                        if (edge) { if (t == 0) { gp1 = 0.f; up1 = 0.f; } if (t <= 1) { gp2 = 0.f; up2 = 0.f; } }
                        const float G = g2[j] * gc + g1[j] * gp1 + g0[j] * gp2;
                        const float U = u2[j] * uc + u1[j] * up1 + u0[j] * up2;
                        r[j] = G * U * __builtin_amdgcn_rcpf(1.f + __builtin_amdgcn_exp2f(-1.4426950408889634f * G));
                    }
                    if (ok) { u32x2 w; w.x = pk2(r[0], r[1]); w.y = pk2(r[2], r[3]); *(u32x2*)(ACT + (size_t)grow * 2816 + col) = w; }
                }
        }
    }
};
}

#define LAS __attribute__((address_space(3)))
typedef unsigned short bf16_t;
typedef short bf16x8 __attribute__((ext_vector_type(8)));
typedef short s16x4 __attribute__((ext_vector_type(4)));
typedef float f32x4 __attribute__((ext_vector_type(4)));
typedef float f32x16 __attribute__((ext_vector_type(16)));
typedef unsigned u32x4 __attribute__((ext_vector_type(4)));
typedef unsigned u32x2 __attribute__((ext_vector_type(2)));
using pg8::pk2;

constexpr int NW = 8, NT_BLK = NW * 64;
constexpr int DM = 1024, NB = 8, SEQ = 4096, NMETA = 16, SL = 4112, MROWS = NB * SL  , MP = 33024  , FF = 2816, DEPTH = 4;
constexpr float EPS = 1e-6f;
static_assert(SL == pg8::SEQ_L, "seq");
constexpr int NM = MP / 256;
constexpr int NM_UP = 133;

constexpr size_t MiB = 1u << 20;
constexpr size_t WS_ROPE = 1 * MiB;
constexpr size_t WS_HM = 2 * MiB;
constexpr size_t WS_W = 4 * MiB;
constexpr size_t WS_XN = 97 * MiB;
constexpr size_t ROWB = (size_t)MP * 2048;
constexpr size_t WS_MO = WS_XN + ROWB;
constexpr size_t WS_R = WS_MO + ROWB;
constexpr size_t WS_END = WS_R + 230 * MiB;
constexpr size_t W_MLA_IN = 0, SZ_MLA_IN = 512 * 1024;
constexpr size_t W_MLA_UQ = W_MLA_IN + 2 * SZ_MLA_IN, SZ_MLA_UQ = 1536 * 256;
constexpr size_t W_MLA_UKV = W_MLA_UQ + 2 * SZ_MLA_UQ, SZ_MLA_UKV = 2048 * 256;
constexpr size_t W_MLA_O = W_MLA_UKV + 2 * SZ_MLA_UKV, SZ_SQ = 1024 * 1024;
constexpr size_t W_SC_IN = W_MLA_O + 2 * SZ_SQ, SZ_3D = 3072 * 1024;
constexpr size_t W_SC_OUT = W_SC_IN + SZ_3D;
constexpr size_t W_DF_IN = W_SC_OUT + SZ_SQ;
constexpr size_t W_DF_O = W_DF_IN + SZ_3D;
constexpr size_t W_UP = W_DF_O + SZ_SQ, SZ_UP = 5632 * 1024;
constexpr size_t W_DN = W_UP + 4 * SZ_UP, SZ_DN = 1024 * 2816;
constexpr size_t W_TOTAL = W_DN + 4 * SZ_DN;
static_assert(WS_W + W_TOTAL * 2 + 8192 <= WS_XN, "weights fit");
constexpr size_t R_NQ = 0, R_NKV = 17 * MiB, R_Q = 34 * MiB, R_C = 34 * MiB, R_K = 131 * MiB;
static_assert(R_K + (size_t)MP * 1536 * 2 <= 230 * MiB && R_Q + (size_t)MP * 1536 * 2 <= R_K && (size_t)MP * 3072 * 2 <= 230 * MiB, "R map");

constexpr int LDS_BYTES = 131072 + 1024;

struct Args { const float* in[22]; float* out; unsigned char* ws; int ph_lo, ph_hi; };

#define GASP __attribute__((address_space(1)))
#define INP(i) ld_inp<(i)>()
template <int I> __device__ __forceinline__ const float* ld_inp() {
    unsigned long long v; asm volatile("s_load_dwordx2 %0, %1, %2\n\ts_waitcnt lgkmcnt(0)" : "=s"(v) : "s"(__builtin_amdgcn_kernarg_segment_ptr()), "i"(I * 8));
    return (const float*)(GASP const float*)v;
}
__device__ __forceinline__ float lane_xor(float v, int lane, int o) { return __builtin_bit_cast(float, __builtin_amdgcn_ds_bpermute((lane ^ o) << 2, __builtin_bit_cast(int, v))); }
__device__ __forceinline__ float wave_sum(float v, int lane) {
#pragma unroll
    for (int o = 1; o < 64; o <<= 1) v += lane_xor(v, lane, o);
    return v;
}
__device__ __forceinline__ float bf2f(unsigned short b) { return __builtin_bit_cast(float, (unsigned)b << 16); }
__device__ __forceinline__ float bflo(unsigned w) { return __builtin_bit_cast(float, w << 16); }
__device__ __forceinline__ float bfhi(unsigned w) { return __builtin_bit_cast(float, w & 0xffff0000u); }
__device__ __forceinline__ float* hrow(float* out, float* hm, int m) {
    const int b = m / SL, t = m - b * SL;
    return t < NMETA ? hm + (size_t)(b * NMETA + t) * DM : out + ((size_t)b * SEQ + (t - NMETA)) * DM;
}

__device__ __forceinline__ void cvt_weight(const float* W, int Ks, int Ns, bf16_t* WT, int Kd, int Nd, int mode, LAS float* scr, int gw, int NGW, int lane, int& base) {
    const int nblk = Nd / 32, nitems = (Kd / 64) * nblk;
    int first = (gw - base) % NGW; if (first < 0) first += NGW;
    base = (base + nitems) % NGW;
    for (int it = first; it < nitems; it += NGW) {
        const int kb = it / nblk, nb = it - kb * nblk, k0 = 64 * kb, p0 = 32 * nb;
        int lc = p0;
        if (mode == 1) { const int pn = p0 >> 8, j = p0 & 255; lc = (j < 128) ? 128 * pn + j : FF + 128 * pn + (j - 128); }
        const bool zero = (lc >= Ns) || (k0 >= Ks);
        { f32x4 v[8];
#pragma unroll
          for (int i = 0; i < 8; ++i) { const int kk = 8 * i + (lane >> 3); v[i] = zero ? (f32x4){0.f, 0.f, 0.f, 0.f} : __builtin_nontemporal_load((const f32x4*)(W + (size_t)(k0 + kk) * Ns + lc + 4 * (lane & 7))); }
#pragma unroll
          for (int i = 0; i < 8; ++i) { const int kk = 8 * i + (lane >> 3); LAS float* d = scr + kk * 33 + 4 * (lane & 7); d[0] = v[i].x; d[1] = v[i].y; d[2] = v[i].z; d[3] = v[i].w; } }
        asm volatile("s_waitcnt lgkmcnt(0)" ::: "memory");
        const int c = lane & 7;
#pragma unroll
        for (int j = 0; j < 4; ++j) { const int n = (lane >> 3) + 8 * j; const LAS float* s = scr + (8 * c) * 33 + n;
            u32x4 o; o.x = pk2(s[0 * 33], s[1 * 33]); o.y = pk2(s[2 * 33], s[3 * 33]); o.z = pk2(s[4 * 33], s[5 * 33]); o.w = pk2(s[6 * 33], s[7 * 33]);
            *(u32x4*)(WT + (size_t)(p0 + n) * Kd + k0 + 8 * c) = o; }
        asm volatile("s_waitcnt lgkmcnt(0)" ::: "memory");
    }
}

__device__ __forceinline__ void rms_store_bf16(const f32x4 (&v)[4], const float* g, bf16_t* orow, int lane) {
    float s = 0.f;
#pragma unroll
    for (int j = 0; j < 4; ++j) s += (v[j].x * v[j].x + v[j].y * v[j].y) + (v[j].z * v[j].z + v[j].w * v[j].w);
    const float r = rsqrtf(wave_sum(s, lane) * (1.f / DM) + EPS);
#pragma unroll
    for (int j = 0; j < 4; ++j) { const f32x4 gg = *(const f32x4*)(g + 4 * lane + 256 * j);
        u32x2 w; w.x = pk2(v[j].x * r * gg.x, v[j].y * r * gg.y); w.y = pk2(v[j].z * r * gg.z, v[j].w * r * gg.w);
        *(u32x2*)(orow + 4 * lane + 256 * j) = w; }
}

__device__ __forceinline__ s16x4 vtr(const LAS unsigned char* p) { typedef short v4i16_t __attribute__((ext_vector_type(4)));
    return __builtin_bit_cast(s16x4, __builtin_amdgcn_ds_read_tr16_b64_v4i16((LAS v4i16_t*)p)); }
__device__ __forceinline__ int crow(int r, int hi) { return (r & 3) + 8 * (r >> 2) + 4 * hi; }
__device__ __forceinline__ float xhalf_max(float m) { auto rr = __builtin_amdgcn_permlane32_swap(__float_as_uint(m), __float_as_uint(m), false, false); return fmaxf(__uint_as_float(rr[0]), __uint_as_float(rr[1])); }
__device__ __forceinline__ float xhalf_sum(float m) { auto rr = __builtin_amdgcn_permlane32_swap(__float_as_uint(m), __float_as_uint(m), false, false); return __uint_as_float(rr[0]) + __uint_as_float(rr[1]); }

template <int DQK, int DV, bool ALIBI, bool DUAL = false, bool FAST = false>
__device__ __forceinline__ void attn_unit(LAS unsigned char* lds, const bf16_t* Qh, int qpitch, const bf16_t* Kh, int kpitch, const bf16_t* Vh, int vpitch, bf16_t* Oh, int opitch,
                                          int q_lo, int q_hi, float c1, float c2, int tid_in, float lam = 0.f, const float* gsub = nullptr, float oscale = 1.f) {
    constexpr int KW = DUAL ? 2 * DQK : DQK;
    constexpr int KP = KW * 2 + 16, VP = DV * 2 + 64, KBYTES = 64 * KP, VBYTES = 64 * VP, BUF = KBYTES + VBYTES;
    constexpr int KCH = KW / 8, VCH = DV / 8, NKC = 64 * KCH, NVC = 64 * VCH, KPT = (NKC + NT_BLK - 1) / NT_BLK, VPT = (NVC + NT_BLK - 1) / NT_BLK;
    static_assert(2 * KBYTES + 3 * VBYTES <= 131072, "attention LDS");
    int tid_ = tid_in; asm volatile("" : "+v"(tid_));
    const int tid = tid_, lane = tid & 63, r32 = lane & 31, hi = lane >> 5; const int wid = __builtin_amdgcn_readfirstlane(tid >> 6);
    const int mapi = DUAL ? (wid >> 2) : 0;
    const int wq0 = q_lo + 32 * (DUAL ? (wid & 3) : wid), qpos = wq0 + r32;
    const int NT = (q_hi + 63) >> 6;
    const int wlast = (wq0 < q_hi) ? ((((wq0 + 31) < (q_hi - 1)) ? (wq0 + 31) : (q_hi - 1)) >> 6) : -1;
    bf16x8 qf[DQK / 16];
    { const int qrow = qpos < SL ? qpos : SL - 1;
#pragma unroll
      for (int st = 0; st < DQK / 16; ++st) { qf[st] = *(const bf16x8*)(Qh + (size_t)qrow * qpitch + mapi * DQK + 16 * st + 8 * hi);
          if (FAST && ALIBI) {
              u32x4 w = __builtin_bit_cast(u32x4, qf[st]);
#pragma unroll
              for (int e = 0; e < 4; ++e) w[e] = pk2(bflo(w[e]) * c1, bfhi(w[e]) * c1);
              qf[st] = __builtin_bit_cast(bf16x8, w); } } }
    f32x16 o[DV / 32];
#pragma unroll
    for (int d = 0; d < DV / 32; ++d) o[d] = f32x16{};
    float mrun = FAST ? 0.f : -INFINITY, lrun = 0.f;
    f32x16 negm = f32x16{}, osum = f32x16{};
    const bf16x8 ones8 = (bf16x8){0x3F80, 0x3F80, 0x3F80, 0x3F80, 0x3F80, 0x3F80, 0x3F80, 0x3F80};
    u32x4 kreg[KPT], vreg[VPT];
#define AT_LOAD(t) do { \
    _Pragma("unroll") for (int i_ = 0; i_ < KPT; ++i_) { const int c_ = tid + NT_BLK * i_; if (c_ < NKC) { const int key_ = c_ / KCH, ch_ = c_ - key_ * KCH; kreg[i_] = *(const u32x4*)(Kh + (size_t)((t) * 64 + key_) * kpitch + ch_ * 8); } } \
    _Pragma("unroll") for (int i_ = 0; i_ < VPT; ++i_) { const int c_ = tid + NT_BLK * i_; if (c_ < NVC) { const int key_ = c_ / VCH, ch_ = c_ - key_ * VCH; vreg[i_] = *(const u32x4*)(Vh + (size_t)((t) * 64 + key_) * vpitch + ch_ * 8); } } } while (0)
#define AT_STORE(kb, vs) do { \
    _Pragma("unroll") for (int i_ = 0; i_ < KPT; ++i_) { const int c_ = tid + NT_BLK * i_; if (c_ < NKC) { const int key_ = c_ / KCH, ch_ = c_ - key_ * KCH; *(LAS u32x4*)(lds + (kb) * KBYTES + key_ * KP + ch_ * 16) = kreg[i_]; } } \
    _Pragma("unroll") for (int i_ = 0; i_ < VPT; ++i_) { const int c_ = tid + NT_BLK * i_; if (c_ < NVC) { const int key_ = c_ / VCH, ch_ = c_ - key_ * VCH; *(LAS u32x4*)(lds + 2 * KBYTES + (vs) * VBYTES + key_ * VP + ch_ * 16) = vreg[i_]; } } } while (0)
    const bool late = wid >= 4;
    AT_LOAD(0); AT_STORE(0, 0);
    __syncthreads();
    const int vb = (4 * hi + ((lane & 15) >> 2)) * VP + (16 * ((lane >> 4) & 1) + 4 * (lane & 3)) * 2;
    bf16x8 pb[4];
#define AT_PV(vslot) do { const LAS unsigned char* vb_ = lds + 2 * KBYTES + (vslot) * VBYTES + vb; \
    _Pragma("unroll") for (int d = 0; d < DV / 32; ++d) _Pragma("unroll") for (int ks = 0; ks < 4; ++ks) { \
        const s16x4 lo_ = vtr(vb_ + (16 * ks) * VP + 64 * d), up_ = vtr(vb_ + (16 * ks + 8) * VP + 64 * d); \
        const bf16x8 a_ = (bf16x8){lo_[0], lo_[1], lo_[2], lo_[3], up_[0], up_[1], up_[2], up_[3]}; \
        o[d] = __builtin_amdgcn_mfma_f32_32x32x16_bf16(a_, pb[ks], o[d], 0, 0, 0); } \
    if (FAST) { _Pragma("unroll") for (int ks = 0; ks < 4; ++ks) osum = __builtin_amdgcn_mfma_f32_32x32x16_bf16(ones8, pb[ks], osum, 0, 0, 0); } } while (0)
    int vprev = 0, vcur = 0, vnext = 1;
    for (int t = 0; t < NT; ++t) {
        const int buf = t & 1;
        if (t + 1 < NT) AT_LOAD(t + 1);
        if (late && t >= 1 && t - 1 <= wlast) AT_PV(vprev);
        if (t <= wlast) {
            const LAS unsigned char* kb_ = lds + buf * KBYTES + r32 * KP + 16 * hi + mapi * (DQK * 2);
            f32x16 s0 = FAST ? negm : f32x16{}, s1 = FAST ? negm : f32x16{};
#pragma unroll
            for (int st = 0; st < DQK / 16; ++st) {
                const bf16x8 a0 = *(const LAS bf16x8*)(kb_ + 32 * st), a1 = *(const LAS bf16x8*)(kb_ + 32 * KP + 32 * st);
                s0 = __builtin_amdgcn_mfma_f32_32x32x16_bf16(a0, qf[st], s0, 0, 0, 0);
                s1 = __builtin_amdgcn_mfma_f32_32x32x16_bf16(a1, qf[st], s1, 0, 0, 0);
            }
            const int kbase = t * 64 + 4 * hi - qpos;
            if (ALIBI) {
                const float b0 = c2 * (float)kbase;
#pragma unroll
                for (int r = 0; r < 16; ++r) { const float kr = (float)((r & 3) + 8 * (r >> 2));
                    if (FAST) { s0[r] += fmaf(c2, kr, b0); s1[r] += fmaf(c2, kr + 32.f, b0); }
                    else { s0[r] = fmaf(s0[r], c1, fmaf(c2, kr, b0)); s1[r] = fmaf(s1[r], c1, fmaf(c2, kr + 32.f, b0)); } }
            }
            if (t * 64 + 63 > wq0) {
#pragma unroll
                for (int r = 0; r < 16; ++r) { const int dk = kbase + (r & 3) + 8 * (r >> 2); if (dk > 0) s0[r] = -INFINITY; if (dk + 32 > 0) s1[r] = -INFINITY; }
            }
            float mx = fmaxf(s0[0], s1[0]);
#pragma unroll
            for (int r = 1; r < 16; ++r) mx = fmaxf(fmaxf(mx, s0[r]), s1[r]);
            if (!FAST) mx = xhalf_max(mx);
            if (FAST) {
                if (t == 0 || __any(mx > 8.f)) {
                    mx = xhalf_max(mx);
                    const float dl = (t == 0) ? mx : fmaxf(mx, 0.f);
                    mrun += dl;
#pragma unroll
                    for (int r = 0; r < 16; ++r) { s0[r] -= dl; s1[r] -= dl; negm[r] = -mrun; }
                    if (t != 0) { const float f = __builtin_amdgcn_exp2f(-dl);
#pragma unroll
                        for (int r = 0; r < 16; ++r) osum[r] *= f;
#pragma unroll
                        for (int d = 0; d < DV / 32; ++d)
#pragma unroll
                            for (int r = 0; r < 16; ++r) o[d][r] *= f; }
                }
#pragma unroll
                for (int r = 0; r < 16; ++r) { s0[r] = __builtin_amdgcn_exp2f(s0[r]); s1[r] = __builtin_amdgcn_exp2f(s1[r]); }
            } else {
            if (!ALIBI) mx *= c1;
            const float mn = fmaxf(mrun, mx);
            if (__any(mn != mrun)) {
                const float alpha = __builtin_amdgcn_exp2f(mrun - mn);
                lrun *= alpha;
#pragma unroll
                for (int d = 0; d < DV / 32; ++d)
#pragma unroll
                    for (int r = 0; r < 16; ++r) o[d][r] *= alpha;
                mrun = mn;
            }
            float ps = 0.f;
#pragma unroll
            for (int r = 0; r < 16; ++r) {
                if (ALIBI) { s0[r] = __builtin_amdgcn_exp2f(s0[r] - mn); s1[r] = __builtin_amdgcn_exp2f(s1[r] - mn); }
                else { s0[r] = __builtin_amdgcn_exp2f(fmaf(s0[r], c1, -mn)); s1[r] = __builtin_amdgcn_exp2f(fmaf(s1[r], c1, -mn)); }
                ps += s0[r] + s1[r]; }
            lrun += ps;
            }
            { u32x4 w;
              w.x = pk2(s0[0], s0[1]); w.y = pk2(s0[2], s0[3]); w.z = pk2(s0[4], s0[5]); w.w = pk2(s0[6], s0[7]); pb[0] = __builtin_bit_cast(bf16x8, w);
              w.x = pk2(s0[8], s0[9]); w.y = pk2(s0[10], s0[11]); w.z = pk2(s0[12], s0[13]); w.w = pk2(s0[14], s0[15]); pb[1] = __builtin_bit_cast(bf16x8, w);
              w.x = pk2(s1[0], s1[1]); w.y = pk2(s1[2], s1[3]); w.z = pk2(s1[4], s1[5]); w.w = pk2(s1[6], s1[7]); pb[2] = __builtin_bit_cast(bf16x8, w);
              w.x = pk2(s1[8], s1[9]); w.y = pk2(s1[10], s1[11]); w.z = pk2(s1[12], s1[13]); w.w = pk2(s1[14], s1[15]); pb[3] = __builtin_bit_cast(bf16x8, w); }
            if (!late) AT_PV(vcur);
        }
        if (t + 1 < NT) AT_STORE(buf ^ 1, vnext);
        __syncthreads();
        vprev = vcur; vcur = vnext; vnext = (vnext == 2) ? 0 : vnext + 1;
    }
    if (late && NT - 1 <= wlast) AT_PV(vprev);
    __syncthreads();
#undef AT_PV
#undef AT_LOAD
#undef AT_STORE
    const float ltot = FAST ? osum[0] : xhalf_sum(lrun), inv = 1.f / ltot;
    if (!DUAL) {
        if (qpos < q_hi) {
            bf16_t* op = Oh + (size_t)qpos * opitch + 4 * hi;
#pragma unroll
            for (int d = 0; d < DV / 32; ++d)
#pragma unroll
                for (int g4 = 0; g4 < 4; ++g4) { u32x2 w; w.x = pk2(o[d][4 * g4] * inv, o[d][4 * g4 + 1] * inv); w.y = pk2(o[d][4 * g4 + 2] * inv, o[d][4 * g4 + 3] * inv);
                    *(u32x2*)(op + 32 * d + 8 * g4) = w; }
        }
    } else {
        LAS f32x4* xo = (LAS f32x4*)lds + (wid & 3) * (DV / 8) * 64 + lane;
        if (wid >= 4) {
#pragma unroll
            for (int d = 0; d < DV / 32; ++d)
#pragma unroll
                for (int g4 = 0; g4 < 4; ++g4) xo[(4 * d + g4) * 64] = (f32x4){o[d][4 * g4] * inv, o[d][4 * g4 + 1] * inv, o[d][4 * g4 + 2] * inv, o[d][4 * g4 + 3] * inv};
        }
        __syncthreads();
        if (wid < 4) {
            float ss = 0.f;
#pragma unroll
            for (int d = 0; d < DV / 32; ++d)
#pragma unroll
                for (int g4 = 0; g4 < 4; ++g4) { const f32x4 o1 = xo[(4 * d + g4) * 64];
#pragma unroll
                    for (int j = 0; j < 4; ++j) { const float v = o[d][4 * g4 + j] * inv - lam * o1[j]; o[d][4 * g4 + j] = v; ss += v * v; } }
            ss = xhalf_sum(ss);
            const float rr = rsqrtf(ss * (1.f / DV) + EPS) * oscale;
            if (qpos < q_hi) {
                bf16_t* op = Oh + (size_t)qpos * opitch + 4 * hi;
#pragma unroll
                for (int d = 0; d < DV / 32; ++d)
#pragma unroll
                    for (int g4 = 0; g4 < 4; ++g4) { const f32x4 gg = *(const f32x4*)(gsub + 32 * d + 8 * g4 + 4 * hi);
                        u32x2 w; w.x = pk2(o[d][4 * g4] * rr * gg.x, o[d][4 * g4 + 1] * rr * gg.y); w.y = pk2(o[d][4 * g4 + 2] * rr * gg.z, o[d][4 * g4 + 3] * rr * gg.w);
                        *(u32x2*)(op + 32 * d + 8 * g4) = w; }
            }
        }
        __syncthreads();
    }
}

template <int MODE, int ABL = 0>
__device__ __forceinline__ void attn_phase(LAS unsigned char* lds, const bf16_t* Qb, const bf16_t* Kb, const bf16_t* Vb, bf16_t* Ob, int vcu, int G, int tid) {
    constexpr float L2E = 1.4426950408889634f;
    for (int flat = vcu; flat < 1024 + 128; flat += G) {
        int bh, ua, ub;
        if (flat < 1024) { const int f = flat & 255; bh = f >> 1; const int p = (f & 1) * 4 + (flat >> 8); ua = 16 - p; ub = 1 + p; }
        else { bh = flat - 1024; ua = 0; ub = -1; }
        const int b = bh >> 4, h = bh & 15;
        const size_t row0 = (size_t)b * SL;
#pragma unroll 1
        for (int k = 0; k < 2; ++k) {
            const int u = k ? ub : ua; if (u < 0) break;
            const int q_lo = u ? 16 + 256 * (u - 1) : 0, q_hi = u ? q_lo + 256 : 16;
            attn_unit<96, 64, false, false, true>(lds, Qb + row0 * 1536 + h * 96, 1536, Kb + row0 * 1536 + h * 96, 1536, Vb + row0 * 1024 + h * 64, 1024, Ob + row0 * 1024 + h * 64, 1024,
                                     q_lo, q_hi, 0.10206207261596577f * L2E, 0.f, tid);
        }
    }
}
__device__ __forceinline__ void diff_attn_phase(LAS unsigned char* lds, const bf16_t* QKV, bf16_t* Y, const float* lq1, const float* lk1, const float* lq2, const float* lk2, const float* gsub,
                                                float lambda_init, int vcu, int G, int tid) {
    constexpr float L2E = 1.4426950408889634f;
    const int lane = tid & 63;
    const float lam = __expf(wave_sum(lq1[lane] * lk1[lane], lane)) - __expf(wave_sum(lq2[lane] * lk2[lane], lane)) + lambda_init;
    for (int flat = vcu; flat < 1024 + 64; flat += G) {
        int bh, ua, ub;
        if (flat < 1024) { const int f = flat & 255; bh = f >> 2; const int p = (f & 3) * 4 + (flat >> 8); ua = 32 - p; ub = 1 + p; }
        else { bh = flat - 1024; ua = 0; ub = -1; }
        const int b = bh >> 3, h = bh & 7;
        const size_t row0 = (size_t)b * SL;
#pragma unroll 1
        for (int k = 0; k < 2; ++k) {
            const int u = k ? ub : ua; if (u < 0) break;
            const int q_lo = u ? 16 + 128 * (u - 1) : 0, q_hi = u ? q_lo + 128 : 16;
            attn_unit<64, 128, true, true, true>(lds, QKV + row0 * 3072 + h * 128, 3072, QKV + row0 * 3072 + 1024 + h * 128, 3072, QKV + row0 * 3072 + 2048 + h * 128, 3072, Y + row0 * 1024 + h * 128, 1024,
                                           q_lo, q_hi, 0.125f * L2E, exp2f(-(float)(h + 1)) * L2E, tid, lam, gsub, 1.f - lambda_init);
        }
    }
}

__device__ __forceinline__ void init_rows(const float* x, const float* meta, float* out, float* hm, const float* g0, bf16_t* XN, int gw, int NGW, int lane) {
    constexpr int RB = 4;
    for (int m0 = gw; m0 < MROWS; m0 += NGW * RB) {
        f32x4 v[RB][4];
#pragma unroll
        for (int k = 0; k < RB; ++k) { const int m = m0 + k * NGW, mc = m < MROWS ? m : MROWS - 1; const int b = mc / SL, t = mc - b * SL;
            const float* src = t < NMETA ? meta + (size_t)t * DM : x + ((size_t)b * SEQ + (t - NMETA)) * DM;
#pragma unroll
            for (int j = 0; j < 4; ++j) v[k][j] = __builtin_nontemporal_load((const f32x4*)(src + 4 * lane + 256 * j)); }
#pragma unroll
        for (int k = 0; k < RB; ++k) { const int m = m0 + k * NGW; if (m < MROWS) { float* h = hrow(out, hm, m);
#pragma unroll
            for (int j = 0; j < 4; ++j) __builtin_nontemporal_store(v[k][j], (f32x4*)(h + 4 * lane + 256 * j));
            rms_store_bf16(v[k], g0, XN + (size_t)m * DM, lane); } }
    }
}
__device__ __forceinline__ void nr_rows(const bf16_t* MO, float* out, float* hm, const float* ga, const float* gb, bf16_t* XN, int gw, int NGW, int lane) {
    constexpr int RB = 4;
    for (int m0 = gw; m0 < MROWS; m0 += NGW * RB) {
        float* h[RB]; u32x2 w[RB][4]; f32x4 hv[RB][4];
#pragma unroll
        for (int k = 0; k < RB; ++k) { const int m = m0 + k * NGW; const int mc = m < MROWS ? m : MROWS - 1; h[k] = hrow(out, hm, mc);
#pragma unroll
            for (int j = 0; j < 4; ++j) { w[k][j] = __builtin_nontemporal_load((const u32x2*)(MO + (size_t)mc * DM + 4 * lane + 256 * j)); hv[k][j] = __builtin_nontemporal_load((const f32x4*)(h[k] + 4 * lane + 256 * j)); } }
        float s[RB];
#pragma unroll
        for (int k = 0; k < RB; ++k) { s[k] = 0.f;
#pragma unroll
            for (int j = 0; j < 4; ++j) { const float a0 = bflo(w[k][j].x), a1 = bfhi(w[k][j].x), a2 = bflo(w[k][j].y), a3 = bfhi(w[k][j].y); s[k] += (a0 * a0 + a1 * a1) + (a2 * a2 + a3 * a3); } }
#pragma unroll
        for (int o = 1; o < 64; o <<= 1) {
#pragma unroll
            for (int k = 0; k < RB; ++k) s[k] += lane_xor(s[k], lane, o); }
        float s2[RB];
#pragma unroll
        for (int k = 0; k < RB; ++k) { const float r = rsqrtf(s[k] * (1.f / DM) + EPS); s2[k] = 0.f;
#pragma unroll
            for (int j = 0; j < 4; ++j) { const f32x4 gg = *(const f32x4*)(ga + 4 * lane + 256 * j);
                const f32x4 y = (f32x4){bflo(w[k][j].x), bfhi(w[k][j].x), bflo(w[k][j].y), bfhi(w[k][j].y)};
                hv[k][j] = hv[k][j] + y * r * gg;
                s2[k] += (hv[k][j].x * hv[k][j].x + hv[k][j].y * hv[k][j].y) + (hv[k][j].z * hv[k][j].z + hv[k][j].w * hv[k][j].w); } }
#pragma unroll
        for (int k = 0; k < RB; ++k) { if (m0 + k * NGW < MROWS) {
#pragma unroll
            for (int j = 0; j < 4; ++j) __builtin_nontemporal_store(hv[k][j], (f32x4*)(h[k] + 4 * lane + 256 * j)); } }
        if (gb) {
#pragma unroll
            for (int o = 1; o < 64; o <<= 1) {
#pragma unroll
                for (int k = 0; k < RB; ++k) s2[k] += lane_xor(s2[k], lane, o); }
#pragma unroll
            for (int k = 0; k < RB; ++k) { const int m = m0 + k * NGW; if (m < MROWS) { const float r2 = rsqrtf(s2[k] * (1.f / DM) + EPS);
#pragma unroll
                for (int j = 0; j < 4; ++j) { const f32x4 gg = *(const f32x4*)(gb + 4 * lane + 256 * j);
                    u32x2 ov; ov.x = pk2(hv[k][j].x * r2 * gg.x, hv[k][j].y * r2 * gg.y); ov.y = pk2(hv[k][j].z * r2 * gg.z, hv[k][j].w * r2 * gg.w);
                    *(u32x2*)(XN + (size_t)m * DM + 4 * lane + 256 * j) = ov; } } }
        }
    }
}
__device__ __forceinline__ void mla_norm_rows(const bf16_t* C, const float* gq, const float* gkv, const float* rope, bf16_t* NQ, bf16_t* NKV, bf16_t* Kb, int gw, int NGW, int lane) {
    constexpr int RB = 4;
    const f32x4 gg = *(const f32x4*)(gq + 4 * lane); const float gk0 = gkv[2 * lane], gk1 = gkv[2 * lane + 1];
    const int e = lane & 31, i = e & 15;
    for (int m0 = gw; m0 < MROWS; m0 += NGW * RB) {
        u32x2 wq[RB]; unsigned wk[RB]; unsigned short xs_[RB], xo_[RB]; float cs[RB], sn[RB];
#pragma unroll
        for (int k = 0; k < RB; ++k) { const int m = m0 + k * NGW, mc = m < MROWS ? m : MROWS - 1; const bf16_t* c = C + (size_t)mc * 512; const int t = mc % SL;
            wq[k] = *(const u32x2*)(c + 4 * lane); wk[k] = *(const unsigned*)(c + 256 + 2 * lane); xs_[k] = c[384 + e]; xo_[k] = c[384 + (e ^ 16)];
            cs[k] = rope[t * 32 + i]; sn[k] = rope[t * 32 + 16 + i]; }
        float sq[RB], skv[RB];
#pragma unroll
        for (int k = 0; k < RB; ++k) { const float a0 = bflo(wq[k].x), a1 = bfhi(wq[k].x), a2 = bflo(wq[k].y), a3 = bfhi(wq[k].y), b0 = bflo(wk[k]), b1 = bfhi(wk[k]);
            sq[k] = a0 * a0 + a1 * a1 + a2 * a2 + a3 * a3; skv[k] = b0 * b0 + b1 * b1; }
#pragma unroll
        for (int o = 1; o < 64; o <<= 1) {
#pragma unroll
            for (int k = 0; k < RB; ++k) { const float t1 = lane_xor(sq[k], lane, o), t2 = lane_xor(skv[k], lane, o); sq[k] += t1; skv[k] += t2; } }
#pragma unroll
        for (int k = 0; k < RB; ++k) { const int m = m0 + k * NGW; if (m < MROWS) {
            const float a0 = bflo(wq[k].x), a1 = bfhi(wq[k].x), a2 = bflo(wq[k].y), a3 = bfhi(wq[k].y), b0 = bflo(wk[k]), b1 = bfhi(wk[k]);
            const float r = rsqrtf(sq[k] * (1.f / 256.f) + EPS), r2 = rsqrtf(skv[k] * (1.f / 128.f) + EPS);
            u32x2 o; o.x = pk2(a0 * r * gg.x, a1 * r * gg.y); o.y = pk2(a2 * r * gg.z, a3 * r * gg.w); *(u32x2*)(NQ + (size_t)m * 256 + 4 * lane) = o;
            *(unsigned*)(NKV + (size_t)m * 256 + 2 * lane) = pk2(b0 * r2 * gk0, b1 * r2 * gk1);
            *(unsigned*)(NKV + (size_t)m * 256 + 128 + 2 * lane) = 0u;
            const float xs = bf2f(xs_[k]), xo = bf2f(xo_[k]);
            const float v = (e < 16) ? (xs * cs[k] - xo * sn[k]) : (xs * cs[k] + xo * sn[k]);
            const unsigned short vb = (unsigned short)pg8::f2bf(v);
            bf16_t* kr = Kb + (size_t)m * 1536 + 64 + e;
#pragma unroll
            for (int q = 0; q < 8; ++q) kr[((lane >> 5) + 2 * q) * 96] = vb; } }
    }
}
__device__ __forceinline__ void sc_rows(const bf16_t* T, const float* cw, bf16_t* Y, int gw, int NGW, int lane) {
    for (int m = gw; m < MROWS; m += NGW) {
        const int t = m % SL;
#pragma unroll
        for (int half = 0; half < 2; ++half) {
            const int col = 8 * lane + 512 * half;
            const bf16_t* p = T + (size_t)m * 3072 + col;
            const u32x4 gb = *(const u32x4*)p;
            u32x4 gc[3], uu[3];
#pragma unroll
            for (int k = 0; k < 3; ++k) { const bool ok = t >= k; const bf16_t* q = p - (ok ? (size_t)k * 3072 : 0);
                gc[k] = *(const u32x4*)(q + 1024); uu[k] = *(const u32x4*)(q + 2048); if (!ok) { gc[k] = (u32x4){0u, 0u, 0u, 0u}; } }
            float w[3][8];
#pragma unroll
            for (int k = 0; k < 3; ++k) { const f32x4 a = *(const f32x4*)(cw + k * DM + col), b2 = *(const f32x4*)(cw + k * DM + col + 4);
                w[k][0] = a.x; w[k][1] = a.y; w[k][2] = a.z; w[k][3] = a.w; w[k][4] = b2.x; w[k][5] = b2.y; w[k][6] = b2.z; w[k][7] = b2.w; }
            unsigned ow[4];
#pragma unroll
            for (int e2 = 0; e2 < 4; ++e2) {
                float r2[2];
#pragma unroll
                for (int q = 0; q < 2; ++q) { const int e = 2 * e2 + q; float acc = 0.f;
#pragma unroll
                    for (int k = 0; k < 3; ++k) { const float g = q ? bfhi(gc[k][e2]) : bflo(gc[k][e2]), u = q ? bfhi(uu[k][e2]) : bflo(uu[k][e2]); acc += w[2 - k][e] * (g * u); }
                    r2[q] = (q ? bfhi(gb[e2]) : bflo(gb[e2])) * acc; }
                ow[e2] = pk2(r2[0], r2[1]);
            }
            *(u32x4*)(Y + (size_t)m * DM + col) = (u32x4){ow[0], ow[1], ow[2], ow[3]};
        }
    }
}
__device__ __forceinline__ void diff_combine_rows(const bf16_t* O01, const float* lq1, const float* lk1, const float* lq2, const float* lk2, const float* gsub, float lambda_init, bf16_t* Y,
                                                  int gw, int NGW, int lane) {
    const float lam = __expf(wave_sum(lq1[lane] * lk1[lane], lane)) - __expf(wave_sum(lq2[lane] * lk2[lane], lane)) + lambda_init;
    const int head = lane >> 3, sub = lane & 7;
    float g[16];
#pragma unroll
    for (int i = 0; i < 16; ++i) g[i] = gsub[16 * sub + i] * (1.f - lambda_init);
    for (int m = gw; m < MROWS; m += NGW) {
        const bf16_t* p0 = O01 + (size_t)m * 2048 + (2 * head) * 128 + 16 * sub;
        const u32x4 a0 = __builtin_nontemporal_load((const u32x4*)p0), a1 = __builtin_nontemporal_load((const u32x4*)(p0 + 8)), b0 = __builtin_nontemporal_load((const u32x4*)(p0 + 128)), b1 = __builtin_nontemporal_load((const u32x4*)(p0 + 136));
        float d[16]; float s = 0.f;
#pragma unroll
        for (int i = 0; i < 4; ++i) {
            d[2 * i] = bflo(a0[i]) - lam * bflo(b0[i]); d[2 * i + 1] = bfhi(a0[i]) - lam * bfhi(b0[i]);
            d[8 + 2 * i] = bflo(a1[i]) - lam * bflo(b1[i]); d[8 + 2 * i + 1] = bfhi(a1[i]) - lam * bfhi(b1[i]); }
#pragma unroll
        for (int i = 0; i < 16; ++i) s += d[i] * d[i];
        s += lane_xor(s, lane, 1); s += lane_xor(s, lane, 2); s += lane_xor(s, lane, 4);
        const float r = rsqrtf(s * (1.f / 128.f) + EPS);
        u32x4 o0, o1;
#pragma unroll
        for (int i = 0; i < 4; ++i) { o0[i] = pk2(d[2 * i] * r * g[2 * i], d[2 * i + 1] * r * g[2 * i + 1]); o1[i] = pk2(d[8 + 2 * i] * r * g[8 + 2 * i], d[9 + 2 * i] * r * g[9 + 2 * i]); }
        bf16_t* q = Y + (size_t)m * DM + head * 128 + 16 * sub;
        *(u32x4*)q = o0; *(u32x4*)(q + 8) = o1;
    }
}

__device__ __forceinline__ void p0_prologue(LAS unsigned char* lds, bf16_t* Wb, float* rope, float* out, float* hm, bf16_t* XN, int gw, int NGW, int lane, int wave, int bx, int tid, int G) {
    const float* norms = INP(2);
    LAS float* scr = (LAS float*)(lds + wave * 16384);
    int cbase = 0;
        for (int j = 0; j < 2; ++j) {
            cvt_weight(INP(3) + (size_t)j * 1024 * 416, 1024, 416, Wb + W_MLA_IN + j * SZ_MLA_IN, 1024, 512, 0, scr, gw, NGW, lane, cbase);
            cvt_weight(INP(6) + (size_t)j * 256 * 1536, 256, 1536, Wb + W_MLA_UQ + j * SZ_MLA_UQ, 256, 1536, 0, scr, gw, NGW, lane, cbase);
            cvt_weight(INP(7) + (size_t)j * 128 * 2048, 128, 2048, Wb + W_MLA_UKV + j * SZ_MLA_UKV, 256, 2048, 0, scr, gw, NGW, lane, cbase);
            cvt_weight(INP(8) + (size_t)j * 1024 * 1024, 1024, 1024, Wb + W_MLA_O + j * SZ_SQ, 1024, 1024, 0, scr, gw, NGW, lane, cbase);
        }
        cvt_weight(INP(9), 1024, 3072, Wb + W_SC_IN, 1024, 3072, 0, scr, gw, NGW, lane, cbase);
        cvt_weight(INP(11), 1024, 1024, Wb + W_SC_OUT, 1024, 1024, 0, scr, gw, NGW, lane, cbase);
        cvt_weight(INP(12), 1024, 3072, Wb + W_DF_IN, 1024, 3072, 0, scr, gw, NGW, lane, cbase);
        cvt_weight(INP(18), 1024, 1024, Wb + W_DF_O, 1024, 1024, 0, scr, gw, NGW, lane, cbase);
        for (int i = 0; i < DEPTH; ++i) {
            cvt_weight(INP(19) + (size_t)i * 1024 * 5632, 1024, 5632, Wb + W_UP + i * SZ_UP, 1024, 5632, 1, scr, gw, NGW, lane, cbase);
            cvt_weight(INP(21) + (size_t)i * 2816 * 1024, 2816, 1024, Wb + W_DN + i * SZ_DN, 2816, 1024, 0, scr, gw, NGW, lane, cbase);
        }
        for (int idx = bx * NT_BLK + tid; idx < SL * 16; idx += G * NT_BLK) {
            const int pos = idx >> 4, i = idx & 15;
            const float invf = exp2f(-(float)(2 * i) * (13.287712379549449f / 32.f));
            const float ang = (float)pos * invf;
            double rev = (double)ang * 0.15915494309189535; rev -= floor(rev);
            const float rf = (float)rev;
            rope[pos * 32 + i] = __builtin_amdgcn_cosf(rf); rope[pos * 32 + 16 + i] = __builtin_amdgcn_sinf(rf);
        }
        init_rows(INP(0), INP(1), out, hm, norms, XN, gw, NGW, lane);
}

#define XB_TMO      128
#define XB_XCNT(j)  (256  + 64 * (j))
#define XB_XSUB(j)  (1280 + 64 * (j))
#define XB_XGEN(j)  (2304 + 64 * (j))
#define XB_TOP      3328
#define XB_TOPGEN   3392
#define XCD_BAR_WORDS 3456
#define XB_SPIN_CAP (1u << 18)
__device__ __forceinline__ unsigned xb_ld(unsigned* p)              { return __hip_atomic_load(p, __ATOMIC_RELAXED, __HIP_MEMORY_SCOPE_AGENT); }
__device__ __forceinline__ unsigned xb_add(unsigned* p, unsigned v) { return __hip_atomic_fetch_add(p, v, __ATOMIC_RELAXED, __HIP_MEMORY_SCOPE_AGENT); }
__device__ __forceinline__ unsigned xb_xcc_id() { return (unsigned)__builtin_amdgcn_s_getreg((3 << 11) | 20) & 0xFu; }
#define XB_SPIN(cond, bar) do { unsigned _sp = 0; while (cond) { __builtin_amdgcn_s_sleep(1); \
    if ((++_sp & 255u) == 0u) { if (xb_ld(&(bar)[XB_TMO])) break; if (_sp > XB_SPIN_CAP) { atomicAdd(&(bar)[XB_TMO], 1u); break; } } } } while (0)
struct XcdBarrier { unsigned* bar; unsigned x; volatile LAS unsigned* st; };
__device__ __forceinline__ XcdBarrier xcd_barrier_post(unsigned* bar, volatile LAS unsigned* st, int tid) {
    XcdBarrier b; b.bar = bar; b.x = xb_xcc_id(); b.st = st;
    if (tid == 0) (void)xb_add(&bar[XB_XCNT(b.x)], 1u);
    return b;
}
__device__ __forceinline__ void xcd_barrier_complete(unsigned* bar, unsigned x, unsigned& nloc, unsigned& nx) {
    const unsigned G = gridDim.x * gridDim.y * gridDim.z;
    unsigned sum, cnt, mine, sp = 0u;
    for (;;) {
        sum = 0u; cnt = 0u; mine = 0u;
#pragma unroll
        for (unsigned j = 0; j < 16; ++j) { const unsigned c = xb_ld(&bar[XB_XCNT(j)]); sum += c; cnt += (c > 0u) ? 1u : 0u; mine = (j == x) ? c : mine; }
        if (sum == G) break;
        __builtin_amdgcn_s_sleep(1);
        if ((++sp & 255u) == 0u) { if (xb_ld(&bar[XB_TMO])) break; if (sp > XB_SPIN_CAP) { atomicAdd(&bar[XB_TMO], 1u); break; } }
    }
    nloc = mine > 0u ? mine : 1u; nx = cnt > 0u ? cnt : 1u;
}
__device__ __forceinline__ void xcd_barrier(const XcdBarrier& b, int tid) {
    asm volatile("s_waitcnt vmcnt(0)" ::: "memory");
    __syncthreads();
    if (tid == 0) {
        unsigned* bar = b.bar; unsigned bx_ = b.x; asm volatile("" : "+s"(bx_));
        __builtin_amdgcn_s_waitcnt(0);
        unsigned nloc = b.st[0], nx = b.st[1];
        if (nloc == 0u) { xcd_barrier_complete(bar, bx_, nloc, nx); b.st[0] = nloc; b.st[1] = nx; }
        const unsigned old = xb_add(&bar[XB_XSUB(bx_)], 1u);
        const unsigned gen = old / nloc;
        if (old + 1u == (gen + 1u) * nloc) {
            __builtin_amdgcn_fence(__ATOMIC_RELEASE, "agent");
            asm volatile("s_waitcnt vmcnt(0)" ::: "memory");
            const unsigned og = xb_add(&bar[XB_TOP], 1u);
            const unsigned tg = og / nx;
            if (og + 1u == (tg + 1u) * nx) xb_add(&bar[XB_TOPGEN], 1u);
            else XB_SPIN(xb_ld(&bar[XB_TOPGEN]) == tg, bar);
            __builtin_amdgcn_fence(__ATOMIC_ACQUIRE, "agent");
            xb_add(&bar[XB_XGEN(bx_)], 1u);
            asm volatile("s_waitcnt vmcnt(0)" ::: "memory");
        } else {
            XB_SPIN(xb_ld(&bar[XB_XGEN(bx_)]) == gen, bar);
            __builtin_amdgcn_fence(__ATOMIC_ACQUIRE, "agent");
            asm volatile("s_waitcnt vmcnt(0)" ::: "memory");
        }
    }
    __syncthreads();
}
template <int K>
__device__ __forceinline__ void tail_gemm(LAS unsigned char* lds, const bf16_t* A, const bf16_t* Bt, int N, bf16_t* C, int ldc, int vcu, int G, int tid) {
    constexpr int ROW0 = 32768;
    const int lane = tid & 63, wave = __builtin_amdgcn_readfirstlane(tid >> 6), l16 = lane & 15, lq = lane >> 4;
    LAS float* red = (LAS float*)lds;
    const int ntn = N / 32, ntiles = 8 * ntn; constexpr int kw = K / 8, NS = kw / 32;
    for (int tile = vcu; tile < ntiles; tile += G) {
        const int tm = tile / ntn, tn = tile - tm * ntn;
        const bf16_t* ap = A + (size_t)(ROW0 + tm * 16 + l16) * K + wave * kw + 8 * lq;
        const bf16_t* bp = Bt + (size_t)(tn * 32 + l16) * K + wave * kw + 8 * lq;
        f32x4 c0 = (f32x4){0.f, 0.f, 0.f, 0.f}, c1 = c0;
        bf16x8 fa[NS], fb0[NS], fb1[NS];
#pragma unroll
        for (int s = 0; s < NS; ++s) { fa[s] = *(const bf16x8*)(ap + 32 * s); fb0[s] = *(const bf16x8*)(bp + 32 * s); fb1[s] = *(const bf16x8*)(bp + (size_t)16 * K + 32 * s); }
#pragma unroll
        for (int s = 0; s < NS; ++s) {
            c0 = __builtin_amdgcn_mfma_f32_16x16x32_bf16(fa[s], fb0[s], c0, 0, 0, 0);
            c1 = __builtin_amdgcn_mfma_f32_16x16x32_bf16(fa[s], fb1[s], c1, 0, 0, 0);
        }
#pragma unroll
        for (int e = 0; e < 4; ++e) { red[wave * 512 + (4 * lq + e) * 32 + l16] = c0[e]; red[wave * 512 + (4 * lq + e) * 32 + 16 + l16] = c1[e]; }
        __syncthreads();
        float s = 0.f;
#pragma unroll
        for (int w = 0; w < 8; ++w) s += red[w * 512 + tid];
        C[(size_t)(ROW0 + tm * 16 + (tid >> 5)) * ldc + tn * 32 + (tid & 31)] = (bf16_t)pg8::f2bf(s);
        __syncthreads();
    }
}
__device__ __forceinline__ int lane_id_opaque() { int l; asm volatile("v_mbcnt_lo_u32_b32 %0, -1, 0\n\tv_mbcnt_hi_u32_b32 %0, -1, %0" : "=v"(l)); return l; }
constexpr int N_PHASES = 33;
#define RPT_1(...) __VA_ARGS__
#define RPT_2(...) __VA_ARGS__ __VA_ARGS__
#define RPT_CAT(a, b) a##b
#define RPT_X(n, ...) RPT_CAT(RPT_, n)(__VA_ARGS__)
#define RPT(n, ...) RPT_X(n, __VA_ARGS__)
#ifndef PROBE_ABL
#define PROBE_ABL -1
#endif
#ifndef REP_ROWS
#define REP_ROWS 1
#endif
#ifndef REP_ATTN
#define REP_ATTN 1
#endif
#ifndef REP_UP
#define REP_UP 1
#endif
#ifndef REP_DN
#define REP_DN 1
#endif
#ifndef REP_MIX
#define REP_MIX 1
#endif
__global__ void __launch_bounds__(NT_BLK, 2) trunk_fwd(Args args) {
    extern __shared__ __attribute__((aligned(16))) unsigned char lds_raw[];
    LAS unsigned char* lds = (LAS unsigned char*)lds_raw;
    unsigned long long wsi = (unsigned long long)args.ws, outi = (unsigned long long)args.out;
#if MK_MULTI
    const int lo = args.ph_lo, hi = args.ph_hi;
#else
    constexpr int lo = 0, hi = N_PHASES;
#endif
    int ph = 0;
    const int wave0 = __builtin_amdgcn_readfirstlane((int)threadIdx.x >> 6);
#define MY_TID() (wave0 * 64 + lane_id_opaque())
#if !MK_MULTI
    volatile LAS unsigned* bst = (volatile LAS unsigned*)(lds + 131072);
    { const int t0 = MY_TID(); if (t0 < 4) bst[t0] = 0u; __syncthreads(); }
    const XcdBarrier xbar = xcd_barrier_post((unsigned*)args.ws, bst, MY_TID());
#endif
#define PH_BEGIN if (lo <= ph && ph < hi) { \
    int tid = MY_TID(), bx = blockIdx.x, G = gridDim.x; asm volatile("" : "+v"(tid), "+s"(bx), "+s"(G), "+s"(wsi), "+s"(outi)); unsigned char* ws = (unsigned char*)(GASP unsigned char*)wsi; float* out = (float*)(GASP float*)outi; \
    const int lane = tid & 63, wave = __builtin_amdgcn_readfirstlane(tid >> 6); \
    const int vcu = (G % 8 == 0) ? (bx % 8) * (G / 8) + bx / 8 : bx; const int gw = vcu * NW + wave, NGW = G * NW; \
    float* hm = (float*)(ws + WS_HM); float* rope = (float*)(ws + WS_ROPE); bf16_t* Wb = (bf16_t*)(ws + WS_W); bf16_t* XN = (bf16_t*)(ws + WS_XN); bf16_t* MO = (bf16_t*)(ws + WS_MO); unsigned char* R = ws + WS_R; \
    const float* norms = INP(2); (void)lane; (void)vcu; (void)gw; (void)NGW; (void)hm; (void)rope; (void)Wb; (void)XN; (void)MO; (void)R; (void)norms; (void)tid;
#if MK_MULTI
#define PH_END } ++ph;
#else
#define PH_END if (ph + 1 < hi) { if (ph == 0) cg::this_grid().sync(); else xcd_barrier(xbar, tid); } } ++ph;
#endif
#define GEMM(EPI, AOVF, Aptr, Btptr, KK, nM_, nN_, Eobj) do { pg8::Gemm g_{(const bf16_t*)(Aptr), (const bf16_t*)(Btptr), (KK)}; pg8::StaticOrder S_; S_.init((nM_), (nN_), G, bx); \
        pg8::gemm_phase<EPI, pg8::StaticOrder, AOVF>(lds, g_, S_, Eobj, tid); } while (0)

#define GEMM_T(Aptr, Btptr, KK, nN_, Cptr, ldc_) do { pg8::EpiBf16 E_{(bf16_t*)(Cptr), (ldc_)}; GEMM(pg8::EpiBf16, false, Aptr, Btptr, KK, 128, nN_, E_); \
        tail_gemm<KK>(lds, (const bf16_t*)(Aptr), (const bf16_t*)(Btptr), (nN_) * 256, (bf16_t*)(Cptr), (ldc_), vcu, G, tid); } while (0)
    PH_BEGIN RPT(REP_ROWS, p0_prologue(lds, Wb, rope, out, hm, XN, gw, NGW, lane, wave, bx, tid, G);) PH_END

    for (int layer = 0; layer < DEPTH; ++layer) {
        const int kind = layer % 3, j = layer / 3;
#define nrm (norms + (size_t)layer * 4 * DM)
        if (kind == 0) {
            PH_BEGIN RPT(REP_MIX, { GEMM_T(XN, Wb + W_MLA_IN + j * SZ_MLA_IN, 1024, 2, (bf16_t*)(R + R_C), 512); }) PH_END
            PH_BEGIN RPT(REP_ROWS, mla_norm_rows((const bf16_t*)(R + R_C), INP(4) + j * 256, INP(5) + j * 128, rope, (bf16_t*)(R + R_NQ), (bf16_t*)(R + R_NKV), (bf16_t*)(R + R_K), gw, NGW, lane);) PH_END
            PH_BEGIN RPT(REP_MIX, { pg8::EpiMlaQ E{(bf16_t*)(R + R_Q), rope}; GEMM(pg8::EpiMlaQ, false, R + R_NQ, Wb + W_MLA_UQ + j * SZ_MLA_UQ, 256, NM, 6, E); } { pg8::EpiMlaKV E{(bf16_t*)(R + R_K), MO}; GEMM(pg8::EpiMlaKV, false, R + R_NKV, Wb + W_MLA_UKV + j * SZ_MLA_UKV, 256, NM, 8, E); }) PH_END
            PH_BEGIN attn_phase<0>(lds, (const bf16_t*)(R + R_Q), (const bf16_t*)(R + R_K), MO, XN, vcu, G, tid); PH_END
            PH_BEGIN RPT(REP_MIX, { GEMM_T(XN, Wb + W_MLA_O + j * SZ_SQ, 1024, 4, MO, 1024); }) PH_END
        } else if (kind == 1) {
            PH_BEGIN RPT(REP_MIX, { GEMM_T(XN, Wb + W_SC_IN, 1024, 12, (bf16_t*)R, 3072); }) PH_END
            PH_BEGIN RPT(REP_ROWS, sc_rows((const bf16_t*)R, INP(10), XN, gw, NGW, lane);) PH_END
            PH_BEGIN RPT(REP_MIX, { GEMM_T(XN, Wb + W_SC_OUT, 1024, 4, MO, 1024); }) PH_END
        } else {
            const float lambda_init = 0.8f - 0.6f * __expf(-0.3f * (float)layer);
            PH_BEGIN RPT(REP_MIX, { GEMM_T(XN, Wb + W_DF_IN, 1024, 12, (bf16_t*)R, 3072); }) PH_END
            PH_BEGIN diff_attn_phase(lds, (const bf16_t*)R, XN, INP(13), INP(14), INP(15), INP(16), INP(17), lambda_init, vcu, G, tid); PH_END
            PH_BEGIN RPT(REP_MIX, { GEMM_T(XN, Wb + W_DF_O, 1024, 4, MO, 1024); }) PH_END
        }
        PH_BEGIN nr_rows(MO, out, hm, nrm + DM, nrm + 2 * DM, XN, gw, NGW, lane); PH_END
        PH_BEGIN RPT(REP_UP, { pg8::EpiFfnUp E{(bf16_t*)R, INP(20) + (size_t)layer * 3 * 5632, MROWS}; GEMM(pg8::EpiFfnUp, true, XN - 2 * DM, Wb + W_UP + layer * SZ_UP, 1024, NM_UP, 22, E); }) PH_END
        PH_BEGIN RPT(REP_DN, { GEMM_T(R, Wb + W_DN + layer * SZ_DN, 2816, 4, MO, 1024); }) PH_END
        PH_BEGIN nr_rows(MO, out, hm, nrm + 3 * DM, (layer + 1 < DEPTH) ? norms + (size_t)(layer + 1) * 4 * DM : nullptr, XN, gw, NGW, lane); PH_END
    }
#undef nrm
#undef PH_BEGIN
#undef PH_END
#undef GEMM
#undef GEMM_T
}

extern "C" void kernel_launch(void* const* d_in, const int* in_sizes, int n_in, void* d_out, int out_size, void* d_ws, size_t ws_size, hipStream_t stream) {
    static int grid = 0;
    if (grid == 0) {
        if (n_in != 22 || out_size != NB * SEQ * DM || ws_size < WS_END) { fprintf(stderr, "kernel_launch: unexpected shapes (n_in %d, out %d, ws %zu < %zu); nothing launched\n", n_in, out_size, ws_size, (size_t)WS_END); grid = -1; return; }
        int dev = 0, cus = 0, per_cu = 0;
        if (hipGetDevice(&dev) != hipSuccess || hipDeviceGetAttribute(&cus, hipDeviceAttributeMultiprocessorCount, dev) != hipSuccess) { grid = -1; return; }
        if (hipFuncSetAttribute((const void*)trunk_fwd, hipFuncAttributeMaxDynamicSharedMemorySize, LDS_BYTES) != hipSuccess) { fprintf(stderr, "kernel_launch: hipFuncSetAttribute failed\n"); grid = -1; return; }
        if (hipOccupancyMaxActiveBlocksPerMultiprocessor(&per_cu, (const void*)trunk_fwd, NT_BLK, LDS_BYTES) != hipSuccess || per_cu < 1) { fprintf(stderr, "kernel_launch: occupancy query says %d\n", per_cu); per_cu = 1; }
        (void)hipGetLastError();
        grid = cus;
    }
    if (grid < 0) return;
    Args a{};
    for (int i = 0; i < 22; ++i) a.in[i] = (const float*)d_in[i];
    a.out = (float*)d_out; a.ws = (unsigned char*)d_ws;
#if MK_MULTI
    for (int p = 0; p < N_PHASES; ++p) { a.ph_lo = p; a.ph_hi = p + 1; hipLaunchKernelGGL(trunk_fwd, dim3(grid), dim3(NT_BLK), LDS_BYTES, stream, a); }
#else
    a.ph_lo = 0; a.ph_hi = N_PHASES;
    if (hipMemsetAsync(d_ws, 0, 16384, stream) != hipSuccess) { fprintf(stderr, "kernel_launch: memset of the barrier words failed\n"); return; }
    void* kargs[] = {&a};
    hipError_t e = hipLaunchCooperativeKernel((const void*)trunk_fwd, dim3(grid), dim3(NT_BLK), kargs, LDS_BYTES, stream);
    if (e != hipSuccess) fprintf(stderr, "kernel_launch: cooperative launch failed: %s (grid %d)\n", hipGetErrorString(e), grid);
#endif
}
```
